# Optimizing an MI355X kernel written in HIP

```python
import jax, jax.numpy as jnp
from jax import lax
import numpy as np

D_MODEL = 1024
BATCH = 2
SEQ = 8192
DEPTH = 2

MIX_WIDTH = D_MODEL
N_MIXERS = 4
GROUP_WIDTH = MIX_WIDTH // N_MIXERS
HEADS_PER_GROUP = 4
HEAD_DIM = GROUP_WIDTH // HEADS_PER_GROUP
SGU_CHUNK = 128
SC_WIDTH = 3
DN_CONV_WIDTH = 4
DN_CHUNK = 64
GLA_CHUNK = 64
GLA_GATE_RANK = 16
GLA_GATE_TEMP = 16.0
D_FF = ((8 * D_MODEL // 3 + 255) // 256) * 256
EPS = 1e-6

_G = GROUP_WIDTH
_H = HEADS_PER_GROUP
IN_SPLITS = (_G, _G,
             _G, _G, _G,
             _G, _G, _G, _H, _H, _G,
             _G, _G, _G, GLA_GATE_RANK, _G)
IN_COLS = sum(IN_SPLITS)

kernel_name = "hybrid_sgu_shortconv_gdn_gla"


def rmsnorm(x, w):
    xf = x.astype(jnp.float32)
    y = xf * lax.rsqrt(jnp.mean(xf * xf, axis=-1, keepdims=True) + EPS)
    return (y * w.astype(jnp.float32)).astype(x.dtype)


def layernorm(x, w, b):
    xf = x.astype(jnp.float32)
    mu = jnp.mean(xf, axis=-1, keepdims=True)
    var = jnp.mean(jnp.square(xf - mu), axis=-1, keepdims=True)
    y = (xf - mu) * lax.rsqrt(var + EPS)
    return (y * w.astype(jnp.float32) + b.astype(jnp.float32)).astype(x.dtype)


def l2norm(t):
    return t * lax.rsqrt(jnp.sum(t * t, axis=-1, keepdims=True) + EPS)


def causal_dwconv(x, w):
    k_width, ch = w.shape
    return lax.conv_general_dilated(
        x, w[:, None, :].astype(x.dtype), window_strides=(1,),
        padding=[(k_width - 1, 0)], dimension_numbers=('NWC', 'WIO', 'NWC'),
        feature_group_count=ch)


def to_heads(t):
    b, s, _ = t.shape
    return t.reshape(b, s, HEADS_PER_GROUP, HEAD_DIM).astype(jnp.float32)


def to_chunks(t, c):
    b, s = t.shape[:2]
    t = t.reshape(b, s // c, c, *t.shape[2:])
    return jnp.moveaxis(t, 3, 1)


def from_chunks(t):
    b, h, n, c, d = t.shape
    return jnp.moveaxis(t, 1, 3).reshape(b, n * c, h, d)


def sgu_mixer(u, v, ln_w, ln_b, w_s, b_s):
    bsz, s, g = u.shape
    n = s // SGU_CHUNK
    u = jax.nn.gelu(u)
    v = layernorm(jax.nn.gelu(v), ln_w, ln_b)
    vc = v.reshape(bsz, n, SGU_CHUNK, HEADS_PER_GROUP, HEAD_DIM)
    mask = jnp.tril(jnp.ones((SGU_CHUNK, SGU_CHUNK), dtype=bool))
    ws = jnp.where(mask, w_s, 0.0).astype(v.dtype)
    mixed = jnp.einsum('hts,bnshd->bnthd', ws, vc) + b_s.T.astype(v.dtype)[None, None, :, :, None]
    return u * mixed.reshape(bsz, s, g)


def short_conv_mixer(gate_b, gate_c, h, w_conv):
    return gate_b * causal_dwconv(gate_c * h, w_conv)


def chunk_gated_delta_rule(q, k, v, g, beta):
    bsz, s, h, dk = q.shape
    dv = v.shape[-1]
    c = DN_CHUNK
    q, k, v = to_chunks(q, c), to_chunks(k, c), to_chunks(v, c)
    g, beta = to_chunks(g, c), to_chunks(beta, c)
    q = q * dk ** -0.5
    gc = jnp.cumsum(g, axis=-1)
    causal = jnp.tril(jnp.ones((c, c), dtype=bool))
    strict = jnp.tril(jnp.ones((c, c), dtype=bool), k=-1)
    decay = jnp.exp(jnp.where(causal, gc[..., :, None] - gc[..., None, :], -jnp.inf))
    kb = k * beta[..., None]
    low = jnp.where(strict, jnp.einsum('bhncd,bhnsd->bhncs', kb, k) * decay, 0.0)
    rhs = jnp.concatenate([v * beta[..., None], kb * jnp.exp(gc)[..., None]], axis=-1)
    sol = lax.linalg.triangular_solve(low, rhs, left_side=True, lower=True, unit_diagonal=True)
    u, w = sol[..., :dv], sol[..., dv:]
    attn = jnp.einsum('bhncd,bhnsd->bhncs', q, k) * decay
    qg = q * jnp.exp(gc)[..., None]
    k_dec = k * jnp.exp(gc[..., -1:] - gc)[..., None]
    chunk_dec = jnp.exp(gc[..., -1])

    def step(state, inp):
        qg_n, w_n, u_n, attn_n, kd_n, dec_n = inp
        v_new = u_n - jnp.einsum('bhcd,bhde->bhce', w_n, state)
        o = jnp.einsum('bhcd,bhde->bhce', qg_n, state) + jnp.einsum('bhcs,bhse->bhce', attn_n, v_new)
        state = state * dec_n[..., None, None] + jnp.einsum('bhcd,bhce->bhde', kd_n, v_new)
        return state, o

    s0 = jnp.zeros((bsz, h, dk, dv), jnp.float32)
    xs = tuple(jnp.moveaxis(t, 2, 0) for t in (qg, w, u, attn, k_dec, chunk_dec))
    _, o = lax.scan(step, s0, xs)
    return from_chunks(jnp.moveaxis(o, 0, 2))


def deltanet_mixer(q, k, v, a, b, z, conv_w, a_log, dt_bias, norm_w):
    bsz, s, _ = q.shape
    qkv = jax.nn.silu(causal_dwconv(jnp.concatenate([q, k, v], axis=-1), conv_w))
    q, k, v = jnp.split(qkv, 3, axis=-1)
    q, k, v = l2norm(to_heads(q)), l2norm(to_heads(k)), to_heads(v)
    g = -jnp.exp(a_log.astype(jnp.float32)) * jax.nn.softplus(a.astype(jnp.float32) + dt_bias.astype(jnp.float32))
    beta = jax.nn.sigmoid(b.astype(jnp.float32))
    o = chunk_gated_delta_rule(q, k, v, g, beta)
    o = rmsnorm(o, norm_w) * jax.nn.silu(to_heads(z))
    return o.reshape(bsz, s, GROUP_WIDTH).astype(z.dtype)


def chunk_gla(q, k, v, log_a):
    bsz, s, h, dk = q.shape
    dv = v.shape[-1]
    c = GLA_CHUNK
    q, k, v, log_a = (to_chunks(t, c) for t in (q, k, v, log_a))
    q = q * dk ** -0.5
    gcum = jnp.cumsum(log_a, axis=3)
    g_mid = gcum[:, :, :, c // 2:c // 2 + 1, :]
    qa = q * jnp.exp(gcum - g_mid)
    ka = k * jnp.exp(g_mid - gcum)
    causal = jnp.tril(jnp.ones((c, c), dtype=bool))
    attn = jnp.where(causal, jnp.einsum('bhncd,bhnsd->bhncs', qa, ka), 0.0)
    o_intra = jnp.einsum('bhncs,bhnse->bhnce', attn, v)
    qg = q * jnp.exp(gcum)
    k_last = k * jnp.exp(gcum[:, :, :, -1:, :] - gcum)
    chunk_dec = jnp.exp(gcum[:, :, :, -1, :])

    def step(state, inp):
        qg_n, kl_n, v_n, dec_n = inp
        o = jnp.einsum('bhcd,bhde->bhce', qg_n, state)
        state = state * dec_n[..., :, None] + jnp.einsum('bhcd,bhce->bhde', kl_n, v_n)
        return state, o

    s0 = jnp.zeros((bsz, h, dk, dv), jnp.float32)
    xs = tuple(jnp.moveaxis(t, 2, 0) for t in (qg, k_last, v, chunk_dec))
    _, o_inter = lax.scan(step, s0, xs)
    return from_chunks(o_intra + jnp.moveaxis(o_inter, 0, 2))


def gla_mixer(q, k, v, g_lr, z, w_gate2, gate_bias, norm_w):
    bsz, s, _ = q.shape
    pre = jnp.einsum('btr,rg->btg', g_lr, w_gate2.astype(g_lr.dtype)).astype(jnp.float32) + gate_bias.astype(jnp.float32)
    log_a = jax.nn.log_sigmoid(pre) / GLA_GATE_TEMP
    o = chunk_gla(to_heads(q), to_heads(k), to_heads(v), to_heads(log_a))
    o = rmsnorm(o, norm_w) * jax.nn.silu(to_heads(z))
    return o.reshape(bsz, s, GROUP_WIDTH).astype(z.dtype)


def swiglu(h, w_gate_up, w_down):
    gu = h @ w_gate_up
    gate, up = jnp.split(gu, 2, axis=-1)
    return (jax.nn.silu(gate) * up) @ w_down


def setup_inputs(seed: int = 0) -> dict:
    key = jax.random.key(seed)
    ks = jax.random.split(key, 24)
    f32 = jnp.float32

    def nrm(k, shape, scale):
        return jax.random.normal(k, shape, f32) * scale

    def gain(k, shape):
        return 1.0 + 0.02 * jax.random.normal(k, shape, f32)

    dt = jnp.exp(jax.random.uniform(ks[11], (DEPTH, HEADS_PER_GROUP), f32, np.log(1e-3), np.log(1e-1)))
    return {
        "x": jax.random.normal(ks[0], (BATCH, SEQ, D_MODEL), f32),
        "norm1_w": gain(ks[1], (DEPTH, D_MODEL)),
        "w_in": nrm(ks[2], (DEPTH, D_MODEL, IN_COLS), D_MODEL ** -0.5),
        "sgu_ln_w": gain(ks[3], (DEPTH, GROUP_WIDTH)),
        "sgu_ln_b": nrm(ks[4], (DEPTH, GROUP_WIDTH), 0.02),
        "sgu_w_spatial": nrm(ks[5], (DEPTH, HEADS_PER_GROUP, SGU_CHUNK, SGU_CHUNK), SGU_CHUNK ** -0.5),
        "sgu_b_spatial": gain(ks[6], (DEPTH, HEADS_PER_GROUP, SGU_CHUNK)),
        "sc_conv_w": nrm(ks[7], (DEPTH, SC_WIDTH, GROUP_WIDTH), SC_WIDTH ** -0.5),
        "dn_conv_w": nrm(ks[8], (DEPTH, DN_CONV_WIDTH, 3 * GROUP_WIDTH), DN_CONV_WIDTH ** -0.5),
        "dn_a_log": jnp.log(jax.random.uniform(ks[9], (DEPTH, HEADS_PER_GROUP), f32, 1.0, 16.0)),
        "dn_dt_bias": dt + jnp.log(-jnp.expm1(-dt)),
        "dn_norm_w": gain(ks[10], (DEPTH, HEAD_DIM)),
        "gla_w_gate2": nrm(ks[12], (DEPTH, GLA_GATE_RANK, GROUP_WIDTH), GLA_GATE_RANK ** -0.5),
        "gla_gate_bias": nrm(ks[13], (DEPTH, GROUP_WIDTH), 0.1),
        "gla_norm_w": gain(ks[14], (DEPTH, HEAD_DIM)),
        "w_out": nrm(ks[15], (DEPTH, MIX_WIDTH, D_MODEL), MIX_WIDTH ** -0.5),
        "norm2_w": gain(ks[16], (DEPTH, D_MODEL)),
        "w_gate_up": nrm(ks[17], (DEPTH, D_MODEL, 2 * D_FF), D_MODEL ** -0.5),
        "w_down": nrm(ks[18], (DEPTH, D_FF, D_MODEL), D_FF ** -0.5),
        "final_norm_w": gain(ks[19], (D_MODEL,)),
    }


def reference(x, norm1_w, w_in, sgu_ln_w, sgu_ln_b, sgu_w_spatial, sgu_b_spatial, sc_conv_w,
              dn_conv_w, dn_a_log, dn_dt_bias, dn_norm_w, gla_w_gate2, gla_gate_bias, gla_norm_w,
              w_out, norm2_w, w_gate_up, w_down, final_norm_w):
    split_idx = [int(i) for i in np.cumsum(IN_SPLITS)[:-1]]
    for l in range(DEPTH):
        h = rmsnorm(x, norm1_w[l])
        p = h @ w_in[l]
        (a_u, a_v, b_b, b_c, b_h, c_q, c_k, c_v, c_a, c_b, c_z,
         d_q, d_k, d_v, d_g, d_z) = jnp.split(p, split_idx, axis=-1)
        y_a = sgu_mixer(a_u, a_v, sgu_ln_w[l], sgu_ln_b[l], sgu_w_spatial[l], sgu_b_spatial[l])
        y_b = short_conv_mixer(b_b, b_c, b_h, sc_conv_w[l])
        y_c = deltanet_mixer(c_q, c_k, c_v, c_a, c_b, c_z, dn_conv_w[l], dn_a_log[l], dn_dt_bias[l], dn_norm_w[l])
        y_d = gla_mixer(d_q, d_k, d_v, d_g, d_z, gla_w_gate2[l], gla_gate_bias[l], gla_norm_w[l])
        mix = jnp.concatenate([y_a, y_b.astype(x.dtype), y_c, y_d], axis=-1)
        x = x + (mix @ w_out[l]).astype(x.dtype)
        x = x + swiglu(rmsnorm(x, norm2_w[l]), w_gate_up[l], w_down[l]).astype(x.dtype)
    return rmsnorm(x, final_norm_w)
```

```cpp
#include <hip/hip_runtime.h>
#include <cstdio>
#include <cstdint>
namespace pg8 {
#define PG8_LAS __attribute__((address_space(3)))
typedef unsigned short bf16_t;
typedef short bf16x8 __attribute__((ext_vector_type(8)));
typedef float f32x4 __attribute__((ext_vector_type(4)));
typedef unsigned u32x4 __attribute__((ext_vector_type(4)));
typedef unsigned u32x2 __attribute__((ext_vector_type(2)));
constexpr int BM = 256, BK = 64, HALF = 128, HTB = HALF * BK * 2  , STAGE_BYTES = 8 * HTB, NXCD = 8, WGM = 8;

__host__ __device__ __forceinline__ int lds_byte(int r, int c) { const int st = (r >> 4) * 2 + (c >> 5), rr = r & 15, cc = c & 31, ob = rr * 64 + cc * 2; return st * 1024 + (ob ^ (((ob >> 9) & 1) << 5)); }
__host__ __device__ __forceinline__ void stage_rc(int b, int& R, int& C) { const int st = b / 1024, sb = b % 1024, swz = sb ^ (((sb >> 9) & 1) << 5); R = (st >> 1) * 16 + swz / 64; C = (st & 1) * 32 + (swz % 64) / 2; }
__host__ __device__ __forceinline__ int perm32(int rho) { const int n = rho >> 4, i = rho & 15; return 8 * (i >> 2) + 4 * n + (i & 3); }

struct Unit { int pm, pn; };
struct Gemm { const bf16_t* A; const bf16_t* Bt; int M, N, K; };

struct StaticOrder {
    int nM, nN, nwg, G, c;
    __host__ __device__ void init(int M, int N, int G_, int c_) { nM = M / BM; nN = N / BM; nwg = nM * nN; G = G_; c = c_; }
    __host__ __device__ bool next(int i, Unit& u) const {
        const long L = (long)i * G + c; if (L >= nwg) return false;
        int wgid = (int)L; { const int q = nwg / NXCD, r = nwg % NXCD, xcd = wgid % NXCD, off = wgid / NXCD; wgid = (xcd < r ? xcd * (q + 1) : r * (q + 1) + (xcd - r) * q) + off; }
        const int nig = WGM * nN, gid = wgid / nig, fm = gid * WGM, gsz = (nM - fm) < WGM ? (nM - fm) : WGM;
        u.pm = fm + ((wgid % nig) % gsz); u.pn = (wgid % nig) / gsz; return true;
    }
    __device__ __forceinline__ void a_ready(const Unit&) const {}
    __device__ __forceinline__ void done(const Unit&) const {}
};

__device__ __forceinline__ unsigned cvt_pk_bf16(float lo, float hi) { unsigned r; asm volatile("v_cvt_pk_bf16_f32 %0, %1, %2" : "=v"(r) : "v"(lo), "v"(hi)); return r; }
constexpr int TOK = 16384;
constexpr float NEPS = 1e-6f;
__device__ __forceinline__ float row_rstd(const float* ssq, int row) { const f32x4 s = *(const f32x4*)(ssq + (size_t)row * 4); return rsqrtf(((s[0] + s[1]) + (s[2] + s[3])) * (1.0f / 1024.0f) + NEPS); }

struct EpiIn {
    static constexpr bool PERM = true, AFTER_DRAIN = false;
    bf16_t* P; float* PS; const float* ssq;
    __device__ __forceinline__ void operator()(const f32x4 (&acc)[2][2][4][2], const Unit& u, int wr, int wc, int fr, int fq) const {
        const int row0 = u.pm * BM + wr * 64 + fr;
#pragma unroll
        for (int ai = 0; ai < 2; ++ai)
#pragma unroll
            for (int m = 0; m < 4; ++m) {
                const int row = row0 + ai * HALF + m * 16; const float rs = row_rstd(ssq, row);
                if (u.pn < 13) {
                    bf16_t* rowp = P + (size_t)u.pn * TOK * 256 + (size_t)row * 256 + wc * 32 + 8 * fq;
#pragma unroll
                    for (int bj = 0; bj < 2; ++bj) { const f32x4 v0 = acc[ai][bj][m][0] * rs, v1 = acc[ai][bj][m][1] * rs; u32x4 w;
                        w.x = cvt_pk_bf16(v0[0], v0[1]); w.y = cvt_pk_bf16(v0[2], v0[3]); w.z = cvt_pk_bf16(v1[0], v1[1]); w.w = cvt_pk_bf16(v1[2], v1[3]);
                        *(u32x4*)(rowp + bj * HALF) = w; }
                } else if (wc == 0) {
                    float* rp = PS + (size_t)row * 32 + 8 * fq;
                    *(f32x4*)rp = acc[ai][0][m][0] * rs; *(f32x4*)(rp + 4) = acc[ai][0][m][1] * rs;
                }
            }
    }
};
struct EpiGU {
    static constexpr bool PERM = true, AFTER_DRAIN = false;
    bf16_t* H; const float* ssq;
    __device__ __forceinline__ void operator()(const f32x4 (&acc)[2][2][4][2], const Unit& u, int wr, int wc, int fr, int fq) const {
        const int row0 = u.pm * BM + wr * 64 + fr;
#pragma unroll
        for (int ai = 0; ai < 2; ++ai)
#pragma unroll
            for (int m = 0; m < 4; ++m) {
                const int row = row0 + ai * HALF + m * 16; const float rs = row_rstd(ssq, row);
                float h[8];
#pragma unroll
                for (int n = 0; n < 2; ++n)
#pragma unroll
                    for (int i = 0; i < 4; ++i) { const float g = acc[ai][0][m][n][i] * rs, up = acc[ai][1][m][n][i] * rs; h[n * 4 + i] = g * up * __builtin_amdgcn_rcpf(1.0f + __expf(-g)); }
                u32x4 w; w.x = cvt_pk_bf16(h[0], h[1]); w.y = cvt_pk_bf16(h[2], h[3]); w.z = cvt_pk_bf16(h[4], h[5]); w.w = cvt_pk_bf16(h[6], h[7]);
                *(u32x4*)(H + (size_t)row * 2816 + u.pn * 128 + wc * 32 + 8 * fq) = w;
            }
    }
};
struct EpiRes {
    static constexpr bool PERM = false, AFTER_DRAIN = true;
    const float* xin; float* xout; bf16_t* xb; float* ssq;
    __device__ __forceinline__ void operator()(const f32x4 (&)[2][2][4][2], const Unit&, int, int, int, int) const {}
    __device__ __forceinline__ void fused(f32x4 (&acc)[2][2][4][2], const Unit& u, int wr, int wc, int fr, int fq, PG8_LAS unsigned char* lds, int wid, int lane) const {
        PG8_LAS float* part = (PG8_LAS float*)lds;
        const int col0 = u.pn * BM + wc * 32 + 4 * fq;
#pragma unroll
        for (int ai = 0; ai < 2; ++ai)
#pragma unroll
            for (int m = 0; m < 4; ++m) {
                const int r = ai * HALF + wr * 64 + m * 16 + fr; const size_t off = (size_t)(u.pm * BM + r) * 1024 + col0; float s = 0.f;
#pragma unroll
                for (int bj = 0; bj < 2; ++bj)
#pragma unroll
                    for (int n = 0; n < 2; ++n) { const f32x4 xo = *(const f32x4*)(xin + off + bj * HALF + n * 16); const f32x4 xn = xo + acc[ai][bj][m][n];
                        *(f32x4*)(xout + off + bj * HALF + n * 16) = xn; s += (xn[0] * xn[0] + xn[1] * xn[1]) + (xn[2] * xn[2] + xn[3] * xn[3]);
                        u32x2 w; w.x = cvt_pk_bf16(xn[0], xn[1]); w.y = cvt_pk_bf16(xn[2], xn[3]); *(u32x2*)(xb + off + bj * HALF + n * 16) = w; }
                s += __shfl_xor(s, 16); s += __shfl_xor(s, 32);
                if (fq == 0) part[r * 4 + wc] = s;
            }
        asm volatile("s_waitcnt lgkmcnt(0)" ::: "memory"); __builtin_amdgcn_s_barrier(); asm volatile("" ::: "memory");
        const int t = wid * 64 + lane;
        if (t < 256) { const f32x4 p = *(const PG8_LAS f32x4*)(part + t * 4); ssq[(size_t)(u.pm * BM + t) * 4 + u.pn] = (p[0] + p[1]) + (p[2] + p[3]); }
        asm volatile("s_waitcnt lgkmcnt(0)" ::: "memory"); __builtin_amdgcn_s_barrier(); asm volatile("" ::: "memory");
    }
};

template <class Epi, class Sched, bool ALIGN_EPI = false, bool SP2 = false>
__device__ __forceinline__ void gemm_phase(PG8_LAS unsigned char* lds, const Gemm g, const Sched& S, const Epi& E) {
    int tid_ = threadIdx.x; asm volatile("" : "+v"(tid_));
    const int tid = tid_, wid = __builtin_amdgcn_readfirstlane(tid >> 6), lane = tid & 63, wr = wid >> 2, wc = wid & 3, fr = lane & 15, fq = lane >> 4;
    const int K = g.K, nt = K / BK;
    unsigned voffA[2], voffB[2];
#pragma unroll
    for (int i = 0; i < 2; ++i) { int R, C; stage_rc(tid * 16 + i * 8192, R, C); const int Rb = Epi::PERM ? ((R & ~31) + perm32(R & 31)) : R;
        voffA[i] = (unsigned)(R * K + C) * 2u; voffB[i] = (unsigned)(Rb * K + C) * 2u; }
    const size_t kstep = (size_t)(BK * 2);
    const size_t hstep = (size_t)HALF * K * 2;
    const size_t tstep = 2 * hstep;
    const unsigned ldsw = (unsigned)wid * 1024u;
    const int aoff = lds_byte(wr * 64 + fr, fq * 8), boff = lds_byte(wc * 32 + fr, fq * 8);
#define PG8_SA(b, h) (((b) * 2 + (h)) * HTB)
#define PG8_SB(b, h) ((4 + (b) * 2 + (h)) * HTB)
#define PG8_STAGE(bufoff, gbase, voff) do { _Pragma("unroll") for (int _i = 0; _i < 2; ++_i) \
        __builtin_amdgcn_global_load_lds((const unsigned*)((const char*)(gbase) + (voff)[_i]), (PG8_LAS unsigned*)(lds + (bufoff) + ldsw + _i * 8192), 16, 0, 0); } while (0)
#define PG8_LDA(dst, b, h) do { _Pragma("unroll") for (int m = 0; m < 4; ++m) _Pragma("unroll") for (int k = 0; k < 2; ++k) dst[m][k] = *(const PG8_LAS bf16x8*)(lds + PG8_SA(b, h) + aoff + m * 2048 + k * 1024); } while (0)
#define PG8_LDB(dst, b, h) do { _Pragma("unroll") for (int n = 0; n < 2; ++n) _Pragma("unroll") for (int k = 0; k < 2; ++k) dst[n][k] = *(const PG8_LAS bf16x8*)(lds + PG8_SB(b, h) + boff + n * 2048 + k * 1024); } while (0)
#define PG8_MMA(ai, bj, At, Bt) do { __builtin_amdgcn_s_setprio(1); _Pragma("unroll") for (int m = 0; m < 4; ++m) _Pragma("unroll") for (int n = 0; n < 2; ++n) _Pragma("unroll") for (int k = 0; k < 2; ++k) \
        acc[ai][bj][m][n] = __builtin_amdgcn_mfma_f32_16x16x32_bf16(Bt[n][k], At[m][k], acc[ai][bj][m][n], 0, 0, 0); __builtin_amdgcn_s_setprio(0); } while (0)
#define PG8_WAIT_V(n) asm volatile("s_waitcnt vmcnt(" #n ")" ::: "memory")
#define PG8_WAIT_L(n) asm volatile("s_waitcnt lgkmcnt(" #n ")" ::: "memory")
#define PG8_BAR __builtin_amdgcn_s_barrier()
#define PG8_SCHED __builtin_amdgcn_sched_barrier(0)
    Unit cur, nxt; int ui = 0;
    if (!S.next(0, cur)) return;
    f32x4 acc[2][2][4][2];
#pragma unroll
    for (int a = 0; a < 2; ++a)
#pragma unroll
        for (int b = 0; b < 2; ++b)
#pragma unroll
            for (int m = 0; m < 4; ++m)
#pragma unroll
                for (int n = 0; n < 2; ++n) acc[a][b][m][n] = (f32x4){0.f, 0.f, 0.f, 0.f};
    bf16x8 At[4][2], B0[2][2], B1[2][2];
    const char* cA = (const char*)g.A + (size_t)cur.pm * tstep; const char* cB = (const char*)g.Bt + (size_t)cur.pn * tstep;
    S.a_ready(cur);
    if constexpr (SP2) {
        PG8_STAGE(PG8_SB(0, 0), cB, voffB); PG8_STAGE(PG8_SB(0, 1), cB + hstep, voffB); PG8_STAGE(PG8_SA(0, 0), cA, voffA); PG8_STAGE(PG8_SA(0, 1), cA + hstep, voffA);
        if (wr == 1) PG8_BAR;
        PG8_WAIT_V(2); PG8_BAR;
        PG8_STAGE(PG8_SB(1, 0), cB + kstep, voffB); PG8_STAGE(PG8_SA(1, 0), cA + kstep, voffA); PG8_STAGE(PG8_SB(1, 1), cB + hstep + kstep, voffB);
        PG8_WAIT_V(6); PG8_BAR;
    } else {
        PG8_STAGE(PG8_SB(0, 0), cB, voffB); PG8_STAGE(PG8_SA(0, 0), cA, voffA); PG8_STAGE(PG8_SB(0, 1), cB + hstep, voffB); PG8_STAGE(PG8_SA(0, 1), cA + hstep, voffA);
        if (wr == 1) PG8_BAR;
        PG8_WAIT_V(4); PG8_BAR;
        PG8_STAGE(PG8_SB(1, 0), cB + kstep, voffB); PG8_STAGE(PG8_SA(1, 0), cA + kstep, voffA); PG8_STAGE(PG8_SB(1, 1), cB + hstep + kstep, voffB);
        PG8_WAIT_V(6); PG8_BAR;
    }
    for (;;) {
        const bool has_next = S.next(ui + 1, nxt);
        const char* nA = has_next ? (const char*)g.A + (size_t)nxt.pm * tstep : cA; const char* nB = has_next ? (const char*)g.Bt + (size_t)nxt.pn * tstep : cB;
        for (int t = 0; t < nt; t += 2) {
            const bool last = (t == nt - 2);
            const char* a1 = cA + (size_t)(t + 1) * kstep;
            const char* a2 = last ? nA : cA + (size_t)(t + 2) * kstep; const char* b2 = last ? nB : cB + (size_t)(t + 2) * kstep;
            const char* a3 = a2 + kstep; const char* b3 = b2 + kstep;
            if (last && has_next) S.a_ready(nxt);
            if constexpr (SP2) {
            PG8_LDB(B0, 0, 0); PG8_LDB(B1, 0, 1); PG8_SCHED; PG8_LDA(At, 0, 0); PG8_STAGE(PG8_SA(1, 1), a1 + hstep, voffA);
            PG8_WAIT_V(8); PG8_WAIT_L(0); PG8_BAR; PG8_MMA(0, 0, At, B0); PG8_MMA(0, 1, At, B1); PG8_BAR; PG8_SCHED;
            PG8_LDA(At, 0, 1); PG8_STAGE(PG8_SB(0, 0), b2, voffB); PG8_STAGE(PG8_SB(0, 1), b2 + hstep, voffB); PG8_STAGE(PG8_SA(0, 0), a2, voffA);
            PG8_WAIT_V(8); PG8_WAIT_L(0); PG8_BAR; PG8_MMA(1, 0, At, B0); PG8_MMA(1, 1, At, B1); PG8_BAR; PG8_SCHED;
            PG8_LDB(B0, 1, 0); PG8_LDB(B1, 1, 1); PG8_SCHED; PG8_LDA(At, 1, 0); PG8_STAGE(PG8_SA(0, 1), a2 + hstep, voffA);
            PG8_WAIT_V(8); PG8_WAIT_L(0); PG8_BAR; PG8_MMA(0, 0, At, B0); PG8_MMA(0, 1, At, B1); PG8_BAR; PG8_SCHED;
            PG8_LDA(At, 1, 1); PG8_STAGE(PG8_SB(1, 0), b3, voffB); PG8_STAGE(PG8_SB(1, 1), b3 + hstep, voffB); PG8_STAGE(PG8_SA(1, 0), a3, voffA);
            PG8_WAIT_V(8); PG8_WAIT_L(0); PG8_BAR; PG8_MMA(1, 0, At, B0); PG8_MMA(1, 1, At, B1); PG8_BAR; PG8_SCHED;
            } else {
            PG8_LDB(B0, 0, 0); PG8_SCHED; PG8_LDA(At, 0, 0); PG8_STAGE(PG8_SA(1, 1), a1 + hstep, voffA);
            PG8_WAIT_L(8); PG8_BAR; PG8_WAIT_L(0); PG8_MMA(0, 0, At, B0); PG8_BAR; PG8_SCHED;
            PG8_LDB(B1, 0, 1); PG8_STAGE(PG8_SB(0, 0), b2, voffB);
            PG8_BAR; PG8_WAIT_L(0); PG8_MMA(0, 1, At, B1); PG8_BAR;
            PG8_LDA(At, 0, 1); PG8_STAGE(PG8_SA(0, 0), a2, voffA);
            PG8_BAR; PG8_WAIT_L(0); PG8_MMA(1, 0, At, B0); PG8_BAR; PG8_SCHED;
            PG8_STAGE(PG8_SB(0, 1), b2 + hstep, voffB);
            PG8_WAIT_V(6); PG8_BAR; PG8_MMA(1, 1, At, B1); PG8_BAR;
            PG8_LDB(B0, 1, 0); PG8_SCHED; PG8_LDA(At, 1, 0); PG8_STAGE(PG8_SA(0, 1), a2 + hstep, voffA);
            PG8_WAIT_L(8); PG8_BAR; PG8_WAIT_L(0); PG8_MMA(0, 0, At, B0); PG8_BAR; PG8_SCHED;
            PG8_LDB(B1, 1, 1); PG8_STAGE(PG8_SB(1, 0), b3, voffB);
            PG8_BAR; PG8_WAIT_L(0); PG8_MMA(0, 1, At, B1); PG8_BAR;
            PG8_LDA(At, 1, 1); PG8_STAGE(PG8_SA(1, 0), a3, voffA);
            PG8_BAR; PG8_WAIT_L(0); PG8_MMA(1, 0, At, B0); PG8_BAR; PG8_SCHED;
            PG8_STAGE(PG8_SB(1, 1), b3 + hstep, voffB);
            PG8_WAIT_V(6); PG8_BAR; PG8_MMA(1, 1, At, B1); PG8_BAR;
            }
        }
        if constexpr (ALIGN_EPI) { if (wr == 0) PG8_BAR; }
        if constexpr (!Epi::AFTER_DRAIN) { E(acc, cur, wr, wc, fr, fq); S.done(cur); }
        if (!has_next) break;
#pragma unroll
        for (int a = 0; a < 2; ++a)
#pragma unroll
            for (int b = 0; b < 2; ++b)
#pragma unroll
                for (int m = 0; m < 4; ++m)
#pragma unroll
                    for (int n = 0; n < 2; ++n) acc[a][b][m][n] = (f32x4){0.f, 0.f, 0.f, 0.f};
        cur = nxt; cA = nA; cB = nB; ++ui;
        if constexpr (ALIGN_EPI) { if (wr == 1) PG8_BAR; }
    }
    PG8_WAIT_V(0);
    if constexpr (!ALIGN_EPI) { if (wr == 0) PG8_BAR; }
    PG8_BAR;
    if constexpr (Epi::AFTER_DRAIN) { E.fused(acc, cur, wr, wc, fr, fq, lds, wid, lane); S.done(cur); }
#undef PG8_SA
#undef PG8_SB
#undef PG8_STAGE
#undef PG8_LDA
#undef PG8_LDB
#undef PG8_MMA
#undef PG8_WAIT_V
#undef PG8_WAIT_L
#undef PG8_BAR
#undef PG8_SCHED
}
}

constexpr int NWAVES = 8;
constexpr int BATCH = 2, SEQ = 8192, D = 1024, M = BATCH * SEQ, G = 256, NH = 4, HD = 64, DFF = 2816, DEPTH = 2;
constexpr int IN_COLS = 3352, NIN = 3584  , NGU = 2 * DFF;
constexpr float EPS = 1e-6f;
enum { T_AU = 0, T_AV, T_BB, T_BC, T_BH, T_CQ, T_CK, T_CV, T_CZ, T_DQ, T_DK, T_DV, T_DZ, NPT };
constexpr size_t MiB = 1u << 20;
constexpr size_t WS_CTL = 0, CTL_ZERO_BYTES = 1 * MiB;
constexpr size_t WS_SSQ1 = 1 * MiB, WS_SSQ2 = WS_SSQ1 + 256 * 1024;
constexpr size_t WS_PS = 2 * MiB;
constexpr size_t WS_W0 = 4 * MiB;
constexpr size_t WOFF_IN = 0, WOFF_OUT = 7 * MiB, WOFF_GU = 9 * MiB, WOFF_DN = 20 * MiB, W_LAYER = 26 * MiB;
constexpr size_t WS_XB = 56 * MiB;
constexpr size_t WS_MIX = 88 * MiB;
constexpr size_t WS_P = 120 * MiB;
constexpr size_t WS_TMP = 224 * MiB;
constexpr size_t WS_END = 256 * MiB;
static_assert(WS_W0 + 2 * W_LAYER <= WS_XB && WS_P + (size_t)NPT * M * 256 * 2 <= WS_TMP && (size_t)M * DFF * 2 <= WS_TMP - WS_P, "ws map");
constexpr int CW_TMO = 0, CW_CODE = 1, CW_BAR = 4096;
constexpr int RING_OFF = 0, RING_BYTES = 131072;
constexpr int LDSCTL_OFF = RING_BYTES, MISC_OFF = LDSCTL_OFF + 320;
constexpr int LDS_BYTES = 147456;

#define GAS __attribute__((address_space(1)))
#define LAS __attribute__((address_space(3)))
typedef unsigned short bf16;
typedef unsigned v4u __attribute__((ext_vector_type(4)));
typedef unsigned v2u __attribute__((ext_vector_type(2)));
typedef float f32x4 __attribute__((ext_vector_type(4)));
typedef float f32x2 __attribute__((ext_vector_type(2)));
typedef short bf16x8 __attribute__((ext_vector_type(8)));
typedef GAS unsigned gu32;
#define RLX_AGENT __ATOMIC_RELAXED, __HIP_MEMORY_SCOPE_AGENT
#define LDS_WAIT() asm volatile("s_waitcnt lgkmcnt(0)" ::: "memory")
#define VM_WAIT() asm volatile("s_waitcnt vmcnt(0)" ::: "memory")
__device__ __forceinline__ unsigned f2bf(float f) { unsigned u = __builtin_bit_cast(unsigned, f); return (u + 0x7fffu + ((u >> 16) & 1u)) >> 16; }
__device__ __forceinline__ unsigned pk2(float lo, float hi) { return f2bf(lo) | (f2bf(hi) << 16); }
__device__ __forceinline__ float bf2f(unsigned short b) { return __builtin_bit_cast(float, (unsigned)b << 16); }
__device__ __forceinline__ float bflo(unsigned w) { return __builtin_bit_cast(float, w << 16); }
__device__ __forceinline__ float bfhi(unsigned w) { return __builtin_bit_cast(float, w & 0xffff0000u); }
__device__ __forceinline__ float siluf(float x) { return x / (1.0f + __expf(-x)); }
__device__ __forceinline__ float sigmoidf(float x) { return 1.0f / (1.0f + __expf(-x)); }
__device__ __forceinline__ float softplusf(float x) { return fmaxf(x, 0.f) + log1pf(__expf(-fabsf(x))); }
__device__ __forceinline__ float geluf(float x) { const float u = 0.7978845608028654f * (x + 0.044715f * x * x * x); return 0.5f * x * (1.0f + tanhf(u)); }
__device__ __forceinline__ float wave_sum(float v) {
#pragma unroll
    for (int o = 1; o < 64; o <<= 1) v += __shfl_xor(v, o);
    return v;
}
#define XB_TMO      128
#define XB_XCNT(j)  (256  + 64 * (j))
#define XB_XSUB(j)  (1280 + 64 * (j))
#define XB_XGEN(j)  (2304 + 64 * (j))
#define XB_TOP      3328
#define XB_TOPGEN   3392
#define XCD_BAR_WORDS 3456
#define XB_SPIN_CAP (1u << 18)

__device__ __forceinline__ unsigned xb_ld(unsigned* p)              { return __hip_atomic_load(p, __ATOMIC_RELAXED, __HIP_MEMORY_SCOPE_AGENT); }
__device__ __forceinline__ unsigned xb_add(unsigned* p, unsigned v) { return __hip_atomic_fetch_add(p, v, __ATOMIC_RELAXED, __HIP_MEMORY_SCOPE_AGENT); }
__device__ __forceinline__ unsigned xb_xcc_id() { return (unsigned)__builtin_amdgcn_s_getreg((3 << 11) | 20) & 0xFu; }
#define XB_SPIN(cond, bar) do { unsigned _sp = 0; while (cond) { __builtin_amdgcn_s_sleep(1); \
    if ((++_sp & 255u) == 0u) { if (xb_ld(&(bar)[XB_TMO])) break; if (_sp > XB_SPIN_CAP) { atomicAdd(&(bar)[XB_TMO], 1u); break; } } } } while (0)

struct XcdBarrier {
    unsigned* bar; unsigned x;
    volatile LAS unsigned* st;
};

__device__ __forceinline__ XcdBarrier xcd_barrier_post(unsigned* bar, volatile LAS unsigned* st) {
    XcdBarrier b; b.bar = bar; b.x = xb_xcc_id(); b.st = st;
    if (threadIdx.x == 0) (void)xb_add(&bar[XB_XCNT(b.x)], 1u);
    return b;
}
__device__ __forceinline__ void xcd_barrier_complete(unsigned* bar, unsigned x, unsigned& nloc, unsigned& nx) {
    const unsigned G = gridDim.x * gridDim.y * gridDim.z;
    unsigned sum, cnt, mine, sp = 0u;
    for (;;) {
        sum = 0u; cnt = 0u; mine = 0u;
#pragma unroll
        for (unsigned j = 0; j < 16; ++j) { const unsigned c = xb_ld(&bar[XB_XCNT(j)]); sum += c; cnt += (c > 0u) ? 1u : 0u; mine = (j == x) ? c : mine; }
        if (sum == G) break;
        __builtin_amdgcn_s_sleep(1);
        if ((++sp & 255u) == 0u) { if (xb_ld(&bar[XB_TMO])) break; if (sp > XB_SPIN_CAP) { atomicAdd(&bar[XB_TMO], 1u); break; } }
    }
    nloc = mine > 0u ? mine : 1u; nx = cnt > 0u ? cnt : 1u;
}

__device__ __forceinline__ void xcd_barrier(const XcdBarrier& b) {
    asm volatile("s_waitcnt vmcnt(0)" ::: "memory");
    __syncthreads();
    if (threadIdx.x == 0) {
        unsigned* bar = b.bar;
        __builtin_amdgcn_s_waitcnt(0);
        unsigned nloc = b.st[0], nx = b.st[1];
        if (nloc == 0u) { xcd_barrier_complete(bar, b.x, nloc, nx); b.st[0] = nloc; b.st[1] = nx; }
        const unsigned old = xb_add(&bar[XB_XSUB(b.x)], 1u);
        const unsigned gen = old / nloc;
        if (old + 1u == (gen + 1u) * nloc) {
            __builtin_amdgcn_fence(__ATOMIC_RELEASE, "agent");
            asm volatile("s_waitcnt vmcnt(0)" ::: "memory");
            const unsigned og = xb_add(&bar[XB_TOP], 1u);
            const unsigned tg = og / nx;
            if (og + 1u == (tg + 1u) * nx) xb_add(&bar[XB_TOPGEN], 1u);
            else XB_SPIN(xb_ld(&bar[XB_TOPGEN]) == tg, bar);
            __builtin_amdgcn_fence(__ATOMIC_ACQUIRE, "agent");
            xb_add(&bar[XB_XGEN(b.x)], 1u);
            asm volatile("s_waitcnt vmcnt(0)" ::: "memory");
        } else {
            XB_SPIN(xb_ld(&bar[XB_XGEN(b.x)]) == gen, bar);
            __builtin_amdgcn_fence(__ATOMIC_ACQUIRE, "agent");
            asm volatile("s_waitcnt vmcnt(0)" ::: "memory");
        }
    }
    __syncthreads();
}

struct Args { const float* in[20]; float* out; unsigned char* ws; int ph_lo, ph_hi, li, pad; };
enum { I_X = 0, I_N1W, I_WIN, I_SLNW, I_SLNB, I_SWS, I_SBS, I_SCW, I_DCW, I_DALOG, I_DDT, I_DNW, I_GW2, I_GB, I_GNW, I_WOUT, I_N2W, I_WGU, I_WDN, I_FNW };
struct Frame {
    LAS unsigned char* lds;
    volatile LAS unsigned* MISC;
    gu32* ctl;
    int tid, lane, wave;
    int vcu, NG;
};

__device__ __forceinline__ int map_win(int d) {
    const int t = d >> 8, j = d & 255;
    if (t < 8) return d;
    if (t == 8) return 2056 + j; if (t == 9) return 2312 + j; if (t == 10) return 2568 + j; if (t == 11) return 2824 + j; if (t == 12) return 3096 + j;
    if (j < 4) return 2048 + j; if (j < 8) return 2052 + (j - 4); if (j < 24) return 3080 + (j - 8); return -1;
}
__device__ __forceinline__ int map_wgu(int d) { const int t = d >> 8, j = d & 255; return j < 128 ? 128 * t + j : DFF + 128 * t + (j - 128); }
template <int MAP> __device__ __forceinline__ void transpose_item(const float* W, int K, int N, int ND, bf16* WT, const float* kscale, LAS float* scr, int item, int lane) {
    const int nblk = ND / 32, kb = item / nblk, nb = item % nblk, k0 = 64 * kb, d0 = 32 * nb;
    const int dd = d0 + (lane & 31); const int sc = MAP == 1 ? map_win(dd) : (MAP == 2 ? map_wgu(dd) : dd);
#pragma unroll 8
    for (int i = 0; i < 32; ++i) { const int kk = 2 * i + (lane >> 5); float v = sc >= 0 ? W[(size_t)(k0 + kk) * N + sc] : 0.f; if (kscale) v *= kscale[k0 + kk]; scr[kk * 33 + (lane & 31)] = v; }
    LDS_WAIT(); asm volatile("" ::: "memory");
    const int c = lane & 7;
#pragma unroll
    for (int j = 0; j < 4; ++j) { const int n = (lane >> 3) + 8 * j; const LAS float* s = scr + (8 * c) * 33 + n;
        v4u o; o.x = pk2(s[0 * 33], s[1 * 33]); o.y = pk2(s[2 * 33], s[3 * 33]); o.z = pk2(s[4 * 33], s[5 * 33]); o.w = pk2(s[6 * 33], s[7 * 33]);
        *(GAS v4u*)(WT + (size_t)(d0 + n) * K + k0 + 8 * c) = o; }
    LDS_WAIT(); asm volatile("" ::: "memory");
}
constexpr int IT_IN = (D / 64) * (NIN / 32), IT_OUT = (D / 64) * (D / 32), IT_GU = (D / 64) * (NGU / 32), IT_DN = (DFF / 64) * (D / 32), IT_LAYER = IT_IN + IT_OUT + IT_GU + IT_DN;
typedef const __attribute__((address_space(4))) Args* KArgsP;
__device__ __forceinline__ KArgsP kargs2() { KArgsP p = (KArgsP)__builtin_amdgcn_kernarg_segment_ptr(); asm volatile("" : "+s"(p)); return p; }
__device__ __forceinline__ void convert_weights(int layer, int sel_mask, LAS float* scr, int gw, int ngw, int lane) {
#pragma unroll 1
    for (int it = gw; it < IT_LAYER; it += ngw) {
        KArgsP a = kargs2();
        unsigned char* wb = a->ws + WS_W0 + (size_t)layer * W_LAYER;
        int r = it;
        if (r < IT_IN) { if (sel_mask & 1) transpose_item<1>(a->in[I_WIN] + (size_t)layer * D * IN_COLS, D, IN_COLS, NIN, (bf16*)(wb + WOFF_IN), a->in[I_N1W] + layer * D, scr, r, lane); continue; } r -= IT_IN;
        if (r < IT_OUT) { if (sel_mask & 2) transpose_item<0>(a->in[I_WOUT] + (size_t)layer * D * D, D, D, D, (bf16*)(wb + WOFF_OUT), nullptr, scr, r, lane); continue; } r -= IT_OUT;
        if (r < IT_GU) { if (sel_mask & 4) transpose_item<2>(a->in[I_WGU] + (size_t)layer * D * NGU, D, NGU, NGU, (bf16*)(wb + WOFF_GU), a->in[I_N2W] + layer * D, scr, r, lane); continue; } r -= IT_GU;
        if (sel_mask & 8) transpose_item<0>(a->in[I_WDN] + (size_t)layer * DFF * D, DFF, D, D, (bf16*)(wb + WOFF_DN), nullptr, scr, r, lane);
    }
}
__device__ __forceinline__ void x_row_prep(const float* xrow, bf16* orow, float* ssq4, int lane) {
    const GAS f32x4* xr = (const GAS f32x4*)xrow + lane; f32x4 v[4]; float s = 0.f;
#pragma unroll
    for (int j = 0; j < 4; ++j) { v[j] = xr[64 * j]; s += (v[j].x * v[j].x + v[j].y * v[j].y) + (v[j].z * v[j].z + v[j].w * v[j].w); }
    s = wave_sum(s);
    GAS unsigned long long* o8 = (GAS unsigned long long*)orow + lane;
#pragma unroll
    for (int j = 0; j < 4; ++j) o8[64 * j] = (unsigned long long)pk2(v[j].x, v[j].y) | ((unsigned long long)pk2(v[j].z, v[j].w) << 32);
    if (lane == 0) *(f32x4*)ssq4 = (f32x4){s, 0.f, 0.f, 0.f};
}
__device__ __forceinline__ void final_row(float* row, const float* ssq4, const float* fw, int lane) {
    const f32x4 s = *(const f32x4*)ssq4; const float rs = rsqrtf(((s[0] + s[1]) + (s[2] + s[3])) * (1.0f / D) + EPS);
    GAS f32x4* xr = (GAS f32x4*)row + lane; const GAS f32x4* wr = (const GAS f32x4*)fw + lane;
#pragma unroll
    for (int j = 0; j < 4; ++j) { const f32x4 v = xr[64 * j], w = wr[64 * j]; xr[64 * j] = v * rs * w; }
}

constexpr int PH_PRO = 0, PH_PER_LAYER = 7, PH_FINAL = 1 + DEPTH * PH_PER_LAYER, N_PHASES = PH_FINAL + 1;
typedef const __attribute__((address_space(4))) Args* KArgs;
__device__ __forceinline__ KArgs kargs() { KArgs p = (KArgs)__builtin_amdgcn_kernarg_segment_ptr(); asm volatile("" : "+s"(p)); return p; }
__global__ void __launch_bounds__(NWAVES * 64, 2) mk_fwd(Args args_unused) {
    extern __shared__ __attribute__((aligned(16))) unsigned char lds[];
    Frame F;
    F.lds = (LAS unsigned char*)lds;
    F.MISC = (volatile LAS unsigned*)(F.lds + MISC_OFF);
    F.tid = threadIdx.x; F.lane = F.tid & 63; F.wave = __builtin_amdgcn_readfirstlane(F.tid >> 6);
    F.NG = gridDim.x; { const int bx = blockIdx.x; F.vcu = (F.NG % 8 == 0) ? (bx % 8) * (F.NG / 8) + bx / 8 : bx; }
    for (int u = F.tid; u < (LDS_BYTES - LDSCTL_OFF) / 4; u += NWAVES * 64) ((LAS unsigned*)(F.lds + LDSCTL_OFF))[u] = 0u;
    __syncthreads();
    int lo, hi; { KArgs a = kargs(); lo = a->ph_lo; hi = a->ph_hi; F.ctl = (gu32*)(a->ws + WS_CTL); }
    XcdBarrier bar; bar.bar = (unsigned*)(F.ctl + CW_BAR); bar.x = 0; bar.st = nullptr;
    if (hi - lo > 1) bar = xcd_barrier_post((unsigned*)(F.ctl + CW_BAR), F.MISC + 8);
#pragma unroll 1
    for (int ph = lo; ph < hi; ++ph) {
        KArgs a = kargs();
        int NG = F.NG, bx = blockIdx.x, vcu = F.vcu, wv = F.wave; asm volatile("" : "+s"(NG), "+s"(bx), "+s"(vcu), "+s"(wv));
        int lane_l = F.lane; asm volatile("" : "+v"(lane_l));
        const int gw = vcu * NWAVES + wv, ngw = NG * NWAVES;
        unsigned char* const ws = a->ws;
        if (ph == PH_PRO) {
            LAS float* scr = (LAS float*)(F.lds + RING_OFF + wv * 16384);
#pragma unroll 1
            for (int l = 0; l < DEPTH; ++l) convert_weights(l, 15, scr, gw, ngw, lane_l);
            const float* x = a->in[I_X];
#pragma unroll 1
            for (int m = gw; m < M; m += ngw) x_row_prep(x + (size_t)m * D, (bf16*)(ws + WS_XB) + (size_t)m * D, (float*)(ws + WS_SSQ2) + (size_t)m * 4, lane_l);
        } else if (ph == PH_FINAL) {
            float* xres = a->out; const float* fw = a->in[I_FNW];
#pragma unroll 1
            for (int m = gw; m < M; m += ngw) final_row(xres + (size_t)m * D, (float*)(ws + WS_SSQ2) + (size_t)m * 4, fw, lane_l);
        } else {
            const int l = (ph - 1) / PH_PER_LAYER, sub = (ph - 1) % PH_PER_LAYER;
            unsigned char* wb = ws + WS_W0 + (size_t)l * W_LAYER;
            if (sub == 0) {
                pg8::Gemm g{(const bf16*)(ws + WS_XB), (const bf16*)(wb + WOFF_IN), M, NIN, D}; pg8::StaticOrder S; S.init(M, NIN, NG, bx);
                pg8::EpiIn E{(bf16*)(ws + WS_P), (float*)(ws + WS_PS), (const float*)(ws + WS_SSQ2)};
                pg8::gemm_phase<pg8::EpiIn, pg8::StaticOrder, true, true>(F.lds + RING_OFF, g, S, E);
            } else if (sub == 4 || sub == 6) {
                const bool dn = (sub == 6);
                pg8::Gemm g{(const bf16*)(ws + (dn ? WS_P : WS_MIX)), (const bf16*)(wb + (dn ? WOFF_DN : WOFF_OUT)), M, D, dn ? DFF : D}; pg8::StaticOrder S; S.init(M, D, NG, bx);
                float* xres = a->out;
                pg8::EpiRes E{(!dn && l == 0) ? a->in[I_X] : xres, xres, (bf16*)(ws + WS_XB), (float*)(ws + (dn ? WS_SSQ2 : WS_SSQ1))};
                if (NG == 256) pg8::gemm_phase<pg8::EpiRes, pg8::StaticOrder, false, true>(F.lds + RING_OFF, g, S, E);
            } else if (sub == 5) {
                pg8::Gemm g{(const bf16*)(ws + WS_XB), (const bf16*)(wb + WOFF_GU), M, NGU, D}; pg8::StaticOrder S; S.init(M, NGU, NG, bx);
                pg8::EpiGU E{(bf16*)(ws + WS_P), (const float*)(ws + WS_SSQ1)};
                pg8::gemm_phase<pg8::EpiGU, pg8::StaticOrder, true, true>(F.lds + RING_OFF, g, S, E);
            } else {
            }
        }
        if (ph + 1 < hi) xcd_barrier(bar);
    }
}

__global__ void __launch_bounds__(256) k_sgu_ln(const bf16* Pav, const float* lnw, const float* lnb, float* VT) {
    const int row = blockIdx.x * 4 + (threadIdx.x >> 6), lane = threadIdx.x & 63;
    const v2u w = *(const v2u*)(Pav + (size_t)row * 256 + 4 * lane);
    float v[4] = {geluf(bflo(w.x)), geluf(bfhi(w.x)), geluf(bflo(w.y)), geluf(bfhi(w.y))};
    const float mu = wave_sum((v[0] + v[1]) + (v[2] + v[3])) * (1.0f / 256.0f);
    float q = 0.f;
#pragma unroll
    for (int i = 0; i < 4; ++i) { v[i] -= mu; q += v[i] * v[i]; }
    const float rstd = rsqrtf(wave_sum(q) * (1.0f / 256.0f) + EPS);
#pragma unroll
    for (int i = 0; i < 4; ++i) VT[(size_t)row * 256 + 4 * lane + i] = v[i] * rstd * lnw[4 * lane + i] + lnb[4 * lane + i];
}
__global__ void __launch_bounds__(256) k_sgu_mix(const bf16* Pau, const float* VT, const float* Wsp, const float* bsp, bf16* MIX) {
    const int t = blockIdx.x, c = threadIdx.x, tt = t & 127, base = t - tt, h = c >> 6;
    const float* wrow = Wsp + ((size_t)h * 128 + tt) * 128; float acc = 0.f;
    for (int s = 0; s <= tt; ++s) acc += wrow[s] * VT[(size_t)(base + s) * 256 + c];
    const float u = geluf(bf2f(Pau[(size_t)t * 256 + c]));
    MIX[(size_t)t * D + c] = (bf16)f2bf(u * (acc + bsp[h * 128 + tt]));
}
__global__ void __launch_bounds__(256) k_shortconv(const bf16* Pbb, const bf16* Pbc, const bf16* Pbh, const float* cw, bf16* MIX) {
    const int t = blockIdx.x, c = threadIdx.x, tb = t & (SEQ - 1); float y = 0.f;
#pragma unroll
    for (int k = 0; k < 3; ++k) { const int o = k - 2; if (tb + o >= 0) y += cw[k * 256 + c] * (bf2f(Pbc[(size_t)(t + o) * 256 + c]) * bf2f(Pbh[(size_t)(t + o) * 256 + c])); }
    MIX[(size_t)t * D + 256 + c] = (bf16)f2bf(bf2f(Pbb[(size_t)t * 256 + c]) * y);
}
__global__ void __launch_bounds__(64) k_scan(const bf16* P, const float* PS, const float* dcw, const float* alog, const float* dtb, const float* dnw,
                                             const float* gw2, const float* gb, const float* gnw, bf16* MIX) {
    __shared__ float sq[64][64], sk[64][64], sv[64][64], sa[64][64];
    __shared__ float salpha[64], sbeta[64];
    const int lane = threadIdx.x, isg = blockIdx.x >> 3, bh = blockIdx.x & 7, b = bh >> 2, h = bh & 3, ch = h * 64 + lane;
    float S[64];
#pragma unroll
    for (int d = 0; d < 64; ++d) S[d] = 0.f;
    const bf16 *Pq = P + (size_t)(isg ? T_DQ : T_CQ) * M * 256, *Pk = P + (size_t)(isg ? T_DK : T_CK) * M * 256, *Pv = P + (size_t)(isg ? T_DV : T_CV) * M * 256, *Pz = P + (size_t)(isg ? T_DZ : T_CZ) * M * 256;
    const float nw = isg ? gnw[lane] : dnw[lane];
    float w2[16];
#pragma unroll
    for (int r = 0; r < 16; ++r) w2[r] = gw2[r * 256 + ch];
    const float gbias = gb[ch], A = __expf(alog[h]), dt = dtb[h];
    float cq[4], ck[4], cv[4];
#pragma unroll
    for (int j = 0; j < 4; ++j) { cq[j] = dcw[j * 768 + ch]; ck[j] = dcw[j * 768 + 256 + ch]; cv[j] = dcw[j * 768 + 512 + ch]; }
    for (int n = 0; n < SEQ / 64; ++n) {
        const int t0 = b * SEQ + n * 64;
        __syncthreads();
        for (int tok = 0; tok < 64; ++tok) {
            const int t = t0 + tok;
            if (!isg) {
                float q = 0.f, k = 0.f, v = 0.f;
#pragma unroll
                for (int j = 0; j < 4; ++j) { const int o = j - 3; if (n * 64 + tok + o >= 0) { const size_t a = (size_t)(t + o) * 256 + ch; q += cq[j] * bf2f(Pq[a]); k += ck[j] * bf2f(Pk[a]); v += cv[j] * bf2f(Pv[a]); } }
                q = siluf(q); k = siluf(k); v = siluf(v);
                q *= rsqrtf(wave_sum(q * q) + EPS) * 0.125f; k *= rsqrtf(wave_sum(k * k) + EPS);
                sq[tok][lane] = q; sk[tok][lane] = k; sv[tok][lane] = v;
                if (lane == 0) { salpha[tok] = __expf(-A * softplusf(PS[(size_t)t * 32 + h] + dt)); sbeta[tok] = sigmoidf(PS[(size_t)t * 32 + 4 + h]); }
            } else {
                const size_t a = (size_t)t * 256 + ch;
                sq[tok][lane] = bf2f(Pq[a]) * 0.125f; sk[tok][lane] = bf2f(Pk[a]); sv[tok][lane] = bf2f(Pv[a]);
                float pre = gbias;
#pragma unroll
                for (int r = 0; r < 16; ++r) pre += PS[(size_t)t * 32 + 8 + r] * w2[r];
                sa[tok][lane] = __expf(-softplusf(-pre) * (1.0f / 16.0f));
            }
        }
        __syncthreads();
        for (int tok = 0; tok < 64; ++tok) {
            const int t = t0 + tok; float o = 0.f;
            if (!isg) {
                const float alpha = salpha[tok], beta = sbeta[tok]; float kS = 0.f;
#pragma unroll
                for (int d = 0; d < 64; ++d) kS += sk[tok][d] * S[d];
                const float vn = beta * (sv[tok][lane] - alpha * kS);
#pragma unroll
                for (int d = 0; d < 64; ++d) { S[d] = alpha * S[d] + sk[tok][d] * vn; o += sq[tok][d] * S[d]; }
            } else {
                const float ve = sv[tok][lane];
#pragma unroll
                for (int d = 0; d < 64; ++d) { S[d] = sa[tok][d] * S[d] + sk[tok][d] * ve; o += sq[tok][d] * S[d]; }
            }
            const float ms = wave_sum(o * o) * (1.0f / 64.0f);
            const float y = o * rsqrtf(ms + EPS) * nw * siluf(bf2f(Pz[(size_t)t * 256 + ch]));
            MIX[(size_t)t * D + (isg ? 768 : 512) + ch] = (bf16)f2bf(y);
        }
    }
}

extern "C" void kernel_launch(void* const* d_in, const int* in_sizes, int n_in, void* d_out, int out_size, void* d_ws, size_t ws_size, hipStream_t stream) {
    static int grid = 0;
    if (grid == 0) {
        if (n_in != 20 || in_sizes[0] != M * D || out_size != M * D || ws_size < WS_END) { fprintf(stderr, "kernel_launch: unexpected shapes (n_in %d in0 %d out %d ws %zu)\n", n_in, n_in > 0 ? in_sizes[0] : -1, out_size, ws_size); grid = -1; return; }
        int dev = 0, cus = 0;
        if (hipGetDevice(&dev) != hipSuccess || hipDeviceGetAttribute(&cus, hipDeviceAttributeMultiprocessorCount, dev) != hipSuccess) { grid = -1; return; }
        if (hipFuncSetAttribute((const void*)mk_fwd, hipFuncAttributeMaxDynamicSharedMemorySize, LDS_BYTES) != hipSuccess) { fprintf(stderr, "kernel_launch: hipFuncSetAttribute failed\n"); grid = -1; return; }
        (void)hipGetLastError();
        grid = cus;
        if (grid != 256) fprintf(stderr, "kernel_launch: %d CUs, expected 256\n", grid);
    }
    if (grid < 0) return;
    (void)hipMemsetAsync((char*)d_ws + WS_CTL, 0, CTL_ZERO_BYTES, stream);
    Args a{};
    for (int i = 0; i < 20; ++i) a.in[i] = (const float*)d_in[i];
    a.out = (float*)d_out; a.ws = (unsigned char*)d_ws;
    unsigned char* ws = (unsigned char*)d_ws;
    const bf16* P = (const bf16*)(ws + WS_P); float* PS = (float*)(ws + WS_PS); bf16* MIX = (bf16*)(ws + WS_MIX); float* VT = (float*)(ws + WS_TMP);
    auto run = [&](int lo, int hi) { a.ph_lo = lo; a.ph_hi = hi; a.li = 0; hipLaunchKernelGGL(mk_fwd, dim3(grid), dim3(NWAVES * 64), LDS_BYTES, stream, a); };
    run(0, 1);
    for (int l = 0; l < DEPTH; ++l) {
        const int base = 1 + l * PH_PER_LAYER;
        run(base, base + 1);
        hipLaunchKernelGGL(k_sgu_ln, dim3(M / 4), dim3(256), 0, stream, P + (size_t)T_AV * M * 256, a.in[I_SLNW] + l * 256, a.in[I_SLNB] + l * 256, VT);
        hipLaunchKernelGGL(k_sgu_mix, dim3(M), dim3(256), 0, stream, P + (size_t)T_AU * M * 256, VT, a.in[I_SWS] + (size_t)l * 4 * 128 * 128, a.in[I_SBS] + l * 4 * 128, MIX);
        hipLaunchKernelGGL(k_shortconv, dim3(M), dim3(256), 0, stream, P + (size_t)T_BB * M * 256, P + (size_t)T_BC * M * 256, P + (size_t)T_BH * M * 256, a.in[I_SCW] + l * 3 * 256, MIX);
        hipLaunchKernelGGL(k_scan, dim3(16), dim3(64), 0, stream, P, PS, a.in[I_DCW] + l * 4 * 768, a.in[I_DALOG] + l * 4, a.in[I_DDT] + l * 4, a.in[I_DNW] + l * 64,
                           a.in[I_GW2] + l * 16 * 256, a.in[I_GB] + l * 256, a.in[I_GNW] + l * 64, MIX);
        run(base + 4, base + 5); run(base + 5, base + 6); run(base + 6, base + 7);
    }
    run(PH_FINAL, PH_FINAL + 1);
}
```

```cpp
#include <hip/hip_runtime.h>
#include <cstdio>
#include <cstdint>
namespace pg8 {
#define PG8_LAS __attribute__((address_space(3)))
typedef unsigned short bf16_t;
typedef short bf16x8 __attribute__((ext_vector_type(8)));
typedef float f32x4 __attribute__((ext_vector_type(4)));
typedef unsigned u32x4 __attribute__((ext_vector_type(4)));
typedef unsigned u32x2 __attribute__((ext_vector_type(2)));
constexpr int BM = 256, BK = 64, HALF = 128, HTB = HALF * BK * 2  , STAGE_BYTES = 8 * HTB, NXCD = 8, WGM = 8;

__host__ __device__ __forceinline__ int lds_byte(int r, int c) { const int st = (r >> 4) * 2 + (c >> 5), rr = r & 15, cc = c & 31, ob = rr * 64 + cc * 2; return st * 1024 + (ob ^ (((ob >> 9) & 1) << 5)); }
__host__ __device__ __forceinline__ void stage_rc(int b, int& R, int& C) { const int st = b / 1024, sb = b % 1024, swz = sb ^ (((sb >> 9) & 1) << 5); R = (st >> 1) * 16 + swz / 64; C = (st & 1) * 32 + (swz % 64) / 2; }
__host__ __device__ __forceinline__ int perm32(int rho) { const int n = rho >> 4, i = rho & 15; return 8 * (i >> 2) + 4 * n + (i & 3); }

struct Unit { int pm, pn; };
struct Gemm { const bf16_t* A; const bf16_t* Bt; int M, N, K; };

struct StaticOrder {
    int nM, nN, nwg, G, c;
    __host__ __device__ void init(int M, int N, int G_, int c_) { nM = M / BM; nN = N / BM; nwg = nM * nN; G = G_; c = c_; }
    __host__ __device__ bool next(int i, Unit& u) const {
        const long L = (long)i * G + c; if (L >= nwg) return false;
        int wgid = (int)L; { const int q = nwg / NXCD, r = nwg % NXCD, xcd = wgid % NXCD, off = wgid / NXCD; wgid = (xcd < r ? xcd * (q + 1) : r * (q + 1) + (xcd - r) * q) + off; }
        const int nig = WGM * nN, gid = wgid / nig, fm = gid * WGM, gsz = (nM - fm) < WGM ? (nM - fm) : WGM;
        u.pm = fm + ((wgid % nig) % gsz); u.pn = (wgid % nig) / gsz; return true;
    }
    __device__ __forceinline__ void a_ready(const Unit&) const {}
    __device__ __forceinline__ void done(const Unit&) const {}
};

__device__ __forceinline__ unsigned cvt_pk_bf16(float lo, float hi) { unsigned r; asm volatile("v_cvt_pk_bf16_f32 %0, %1, %2" : "=v"(r) : "v"(lo), "v"(hi)); return r; }
constexpr int TOK = 16384;
constexpr float NEPS = 1e-6f;
__device__ __forceinline__ float row_rstd(const float* ssq, int row) { const f32x4 s = *(const f32x4*)(ssq + (size_t)row * 4); return rsqrtf(((s[0] + s[1]) + (s[2] + s[3])) * (1.0f / 1024.0f) + NEPS); }

struct EpiIn {
    static constexpr bool PERM = true, AFTER_DRAIN = false;
    bf16_t* P; float* PS; const float* ssq;
    __device__ __forceinline__ void operator()(const f32x4 (&acc)[2][2][4][2], const Unit& u, int wr, int wc, int fr, int fq) const {
        const int row0 = u.pm * BM + wr * 64 + fr;
#pragma unroll
        for (int ai = 0; ai < 2; ++ai)
#pragma unroll
            for (int m = 0; m < 4; ++m) {
                const int row = row0 + ai * HALF + m * 16; const float rs = row_rstd(ssq, row);
                if (u.pn < 13) {
                    bf16_t* rowp = P + (size_t)u.pn * TOK * 256 + (size_t)row * 256 + wc * 32 + 8 * fq;
#pragma unroll
                    for (int bj = 0; bj < 2; ++bj) { const f32x4 v0 = acc[ai][bj][m][0] * rs, v1 = acc[ai][bj][m][1] * rs; u32x4 w;
                        w.x = cvt_pk_bf16(v0[0], v0[1]); w.y = cvt_pk_bf16(v0[2], v0[3]); w.z = cvt_pk_bf16(v1[0], v1[1]); w.w = cvt_pk_bf16(v1[2], v1[3]);
                        *(u32x4*)(rowp + bj * HALF) = w; }
                } else if (wc == 0) {
                    float* rp = PS + (size_t)row * 32 + 8 * fq;
                    *(f32x4*)rp = acc[ai][0][m][0] * rs; *(f32x4*)(rp + 4) = acc[ai][0][m][1] * rs;
                }
            }
    }
};
struct EpiGU {
    static constexpr bool PERM = true, AFTER_DRAIN = false;
    bf16_t* H; const float* ssq;
    __device__ __forceinline__ void operator()(const f32x4 (&acc)[2][2][4][2], const Unit& u, int wr, int wc, int fr, int fq) const {
        const int row0 = u.pm * BM + wr * 64 + fr;
#pragma unroll
        for (int ai = 0; ai < 2; ++ai)
#pragma unroll
            for (int m = 0; m < 4; ++m) {
                const int row = row0 + ai * HALF + m * 16; const float rs = row_rstd(ssq, row);
                float h[8];
#pragma unroll
                for (int n = 0; n < 2; ++n)
#pragma unroll
                    for (int i = 0; i < 4; ++i) { const float g = acc[ai][0][m][n][i] * rs, up = acc[ai][1][m][n][i] * rs; h[n * 4 + i] = g * up * __builtin_amdgcn_rcpf(1.0f + __expf(-g)); }
                u32x4 w; w.x = cvt_pk_bf16(h[0], h[1]); w.y = cvt_pk_bf16(h[2], h[3]); w.z = cvt_pk_bf16(h[4], h[5]); w.w = cvt_pk_bf16(h[6], h[7]);
                *(u32x4*)(H + (size_t)row * 2816 + u.pn * 128 + wc * 32 + 8 * fq) = w;
            }
    }
};
struct EpiRes {
    static constexpr bool PERM = false, AFTER_DRAIN = true;
    const float* xin; float* xout; bf16_t* xb; float* ssq;
    __device__ __forceinline__ void operator()(const f32x4 (&)[2][2][4][2], const Unit&, int, int, int, int) const {}
    __device__ __forceinline__ void fused(f32x4 (&acc)[2][2][4][2], const Unit& u, int wr, int wc, int fr, int fq, PG8_LAS unsigned char* lds, int wid, int lane) const {
        PG8_LAS float* part = (PG8_LAS float*)lds;
        const int col0 = u.pn * BM + wc * 32 + 4 * fq;
#pragma unroll
        for (int ai = 0; ai < 2; ++ai)
#pragma unroll
            for (int m = 0; m < 4; ++m) {
                const int r = ai * HALF + wr * 64 + m * 16 + fr; const size_t off = (size_t)(u.pm * BM + r) * 1024 + col0; float s = 0.f;
#pragma unroll
                for (int bj = 0; bj < 2; ++bj)
#pragma unroll
                    for (int n = 0; n < 2; ++n) { const f32x4 xo = *(const f32x4*)(xin + off + bj * HALF + n * 16); const f32x4 xn = xo + acc[ai][bj][m][n];
                        *(f32x4*)(xout + off + bj * HALF + n * 16) = xn; s += (xn[0] * xn[0] + xn[1] * xn[1]) + (xn[2] * xn[2] + xn[3] * xn[3]);
                        u32x2 w; w.x = cvt_pk_bf16(xn[0], xn[1]); w.y = cvt_pk_bf16(xn[2], xn[3]); *(u32x2*)(xb + off + bj * HALF + n * 16) = w; }
                s += __shfl_xor(s, 16); s += __shfl_xor(s, 32);
                if (fq == 0) part[r * 4 + wc] = s;
            }
        asm volatile("s_waitcnt lgkmcnt(0)" ::: "memory"); __builtin_amdgcn_s_barrier(); asm volatile("" ::: "memory");
        const int t = wid * 64 + lane;
        if (t < 256) { const f32x4 p = *(const PG8_LAS f32x4*)(part + t * 4); ssq[(size_t)(u.pm * BM + t) * 4 + u.pn] = (p[0] + p[1]) + (p[2] + p[3]); }
        asm volatile("s_waitcnt lgkmcnt(0)" ::: "memory"); __builtin_amdgcn_s_barrier(); asm volatile("" ::: "memory");
    }
};

template <class Epi, class Sched, bool ALIGN_EPI = false, bool SP2 = false>
__device__ __forceinline__ void gemm_phase(PG8_LAS unsigned char* lds, const Gemm g, const Sched& S, const Epi& E) {
    int tid_ = threadIdx.x; asm volatile("" : "+v"(tid_));
    const int tid = tid_, wid = __builtin_amdgcn_readfirstlane(tid >> 6), lane = tid & 63, wr = wid >> 2, wc = wid & 3, fr = lane & 15, fq = lane >> 4;
    const int K = g.K, nt = K / BK;
    unsigned voffA[2], voffB[2];
#pragma unroll
    for (int i = 0; i < 2; ++i) { int R, C; stage_rc(tid * 16 + i * 8192, R, C); const int Rb = Epi::PERM ? ((R & ~31) + perm32(R & 31)) : R;
        voffA[i] = (unsigned)(R * K + C) * 2u; voffB[i] = (unsigned)(Rb * K + C) * 2u; }
    const size_t kstep = (size_t)(BK * 2);
    const size_t hstep = (size_t)HALF * K * 2;
    const size_t tstep = 2 * hstep;
    const unsigned ldsw = (unsigned)wid * 1024u;
    const int aoff = lds_byte(wr * 64 + fr, fq * 8), boff = lds_byte(wc * 32 + fr, fq * 8);
#define PG8_SA(b, h) (((b) * 2 + (h)) * HTB)
#define PG8_SB(b, h) ((4 + (b) * 2 + (h)) * HTB)
#define PG8_STAGE(bufoff, gbase, voff) do { _Pragma("unroll") for (int _i = 0; _i < 2; ++_i) \
        __builtin_amdgcn_global_load_lds((const unsigned*)((const char*)(gbase) + (voff)[_i]), (PG8_LAS unsigned*)(lds + (bufoff) + ldsw + _i * 8192), 16, 0, 0); } while (0)
#define PG8_LDA(dst, b, h) do { _Pragma("unroll") for (int m = 0; m < 4; ++m) _Pragma("unroll") for (int k = 0; k < 2; ++k) dst[m][k] = *(const PG8_LAS bf16x8*)(lds + PG8_SA(b, h) + aoff + m * 2048 + k * 1024); } while (0)
#define PG8_LDB(dst, b, h) do { _Pragma("unroll") for (int n = 0; n < 2; ++n) _Pragma("unroll") for (int k = 0; k < 2; ++k) dst[n][k] = *(const PG8_LAS bf16x8*)(lds + PG8_SB(b, h) + boff + n * 2048 + k * 1024); } while (0)
#define PG8_MMA(ai, bj, At, Bt) do { __builtin_amdgcn_s_setprio(1); _Pragma("unroll") for (int m = 0; m < 4; ++m) _Pragma("unroll") for (int n = 0; n < 2; ++n) _Pragma("unroll") for (int k = 0; k < 2; ++k) \
        acc[ai][bj][m][n] = __builtin_amdgcn_mfma_f32_16x16x32_bf16(Bt[n][k], At[m][k], acc[ai][bj][m][n], 0, 0, 0); __builtin_amdgcn_s_setprio(0); } while (0)
#define PG8_WAIT_V(n) asm volatile("s_waitcnt vmcnt(" #n ")" ::: "memory")
#define PG8_WAIT_L(n) asm volatile("s_waitcnt lgkmcnt(" #n ")" ::: "memory")
#define PG8_BAR __builtin_amdgcn_s_barrier()
#define PG8_SCHED __builtin_amdgcn_sched_barrier(0)
    Unit cur, nxt; int ui = 0;
    if (!S.next(0, cur)) return;
    f32x4 acc[2][2][4][2];
#pragma unroll
    for (int a = 0; a < 2; ++a)
#pragma unroll
        for (int b = 0; b < 2; ++b)
#pragma unroll
            for (int m = 0; m < 4; ++m)
#pragma unroll
                for (int n = 0; n < 2; ++n) acc[a][b][m][n] = (f32x4){0.f, 0.f, 0.f, 0.f};
    bf16x8 At[4][2], B0[2][2], B1[2][2];
    const char* cA = (const char*)g.A + (size_t)cur.pm * tstep; const char* cB = (const char*)g.Bt + (size_t)cur.pn * tstep;
    S.a_ready(cur);
    if constexpr (SP2) {
        PG8_STAGE(PG8_SB(0, 0), cB, voffB); PG8_STAGE(PG8_SB(0, 1), cB + hstep, voffB); PG8_STAGE(PG8_SA(0, 0), cA, voffA); PG8_STAGE(PG8_SA(0, 1), cA + hstep, voffA);
        if (wr == 1) PG8_BAR;
        PG8_WAIT_V(2); PG8_BAR;
        PG8_STAGE(PG8_SB(1, 0), cB + kstep, voffB); PG8_STAGE(PG8_SA(1, 0), cA + kstep, voffA); PG8_STAGE(PG8_SB(1, 1), cB + hstep + kstep, voffB);
        PG8_WAIT_V(6); PG8_BAR;
    } else {
        PG8_STAGE(PG8_SB(0, 0), cB, voffB); PG8_STAGE(PG8_SA(0, 0), cA, voffA); PG8_STAGE(PG8_SB(0, 1), cB + hstep, voffB); PG8_STAGE(PG8_SA(0, 1), cA + hstep, voffA);
        if (wr == 1) PG8_BAR;
        PG8_WAIT_V(4); PG8_BAR;
        PG8_STAGE(PG8_SB(1, 0), cB + kstep, voffB); PG8_STAGE(PG8_SA(1, 0), cA + kstep, voffA); PG8_STAGE(PG8_SB(1, 1), cB + hstep + kstep, voffB);
        PG8_WAIT_V(6); PG8_BAR;
    }
    for (;;) {
        const bool has_next = S.next(ui + 1, nxt);
        const char* nA = has_next ? (const char*)g.A + (size_t)nxt.pm * tstep : cA; const char* nB = has_next ? (const char*)g.Bt + (size_t)nxt.pn * tstep : cB;
        for (int t = 0; t < nt; t += 2) {
            const bool last = (t == nt - 2);
            const char* a1 = cA + (size_t)(t + 1) * kstep;
            const char* a2 = last ? nA : cA + (size_t)(t + 2) * kstep; const char* b2 = last ? nB : cB + (size_t)(t + 2) * kstep;
            const char* a3 = a2 + kstep; const char* b3 = b2 + kstep;
            if (last && has_next) S.a_ready(nxt);
            if constexpr (SP2) {
            PG8_LDB(B0, 0, 0); PG8_LDB(B1, 0, 1); PG8_SCHED; PG8_LDA(At, 0, 0); PG8_STAGE(PG8_SA(1, 1), a1 + hstep, voffA);
            PG8_WAIT_V(8); PG8_WAIT_L(0); PG8_BAR; PG8_MMA(0, 0, At, B0); PG8_MMA(0, 1, At, B1); PG8_BAR; PG8_SCHED;
            PG8_LDA(At, 0, 1); PG8_STAGE(PG8_SB(0, 0), b2, voffB); PG8_STAGE(PG8_SB(0, 1), b2 + hstep, voffB); PG8_STAGE(PG8_SA(0, 0), a2, voffA);
            PG8_WAIT_V(8); PG8_WAIT_L(0); PG8_BAR; PG8_MMA(1, 0, At, B0); PG8_MMA(1, 1, At, B1); PG8_BAR; PG8_SCHED;
            PG8_LDB(B0, 1, 0); PG8_LDB(B1, 1, 1); PG8_SCHED; PG8_LDA(At, 1, 0); PG8_STAGE(PG8_SA(0, 1), a2 + hstep, voffA);
            PG8_WAIT_V(8); PG8_WAIT_L(0); PG8_BAR; PG8_MMA(0, 0, At, B0); PG8_MMA(0, 1, At, B1); PG8_BAR; PG8_SCHED;
            PG8_LDA(At, 1, 1); PG8_STAGE(PG8_SB(1, 0), b3, voffB); PG8_STAGE(PG8_SB(1, 1), b3 + hstep, voffB); PG8_STAGE(PG8_SA(1, 0), a3, voffA);
            PG8_WAIT_V(8); PG8_WAIT_L(0); PG8_BAR; PG8_MMA(1, 0, At, B0); PG8_MMA(1, 1, At, B1); PG8_BAR; PG8_SCHED;
            } else {
            PG8_LDB(B0, 0, 0); PG8_SCHED; PG8_LDA(At, 0, 0); PG8_STAGE(PG8_SA(1, 1), a1 + hstep, voffA);
            PG8_WAIT_L(8); PG8_BAR; PG8_WAIT_L(0); PG8_MMA(0, 0, At, B0); PG8_BAR; PG8_SCHED;
            PG8_LDB(B1, 0, 1); PG8_STAGE(PG8_SB(0, 0), b2, voffB);
            PG8_BAR; PG8_WAIT_L(0); PG8_MMA(0, 1, At, B1); PG8_BAR;
            PG8_LDA(At, 0, 1); PG8_STAGE(PG8_SA(0, 0), a2, voffA);
            PG8_BAR; PG8_WAIT_L(0); PG8_MMA(1, 0, At, B0); PG8_BAR; PG8_SCHED;
            PG8_STAGE(PG8_SB(0, 1), b2 + hstep, voffB);
            PG8_WAIT_V(6); PG8_BAR; PG8_MMA(1, 1, At, B1); PG8_BAR;
            PG8_LDB(B0, 1, 0); PG8_SCHED; PG8_LDA(At, 1, 0); PG8_STAGE(PG8_SA(0, 1), a2 + hstep, voffA);
            PG8_WAIT_L(8); PG8_BAR; PG8_WAIT_L(0); PG8_MMA(0, 0, At, B0); PG8_BAR; PG8_SCHED;
            PG8_LDB(B1, 1, 1); PG8_STAGE(PG8_SB(1, 0), b3, voffB);
            PG8_BAR; PG8_WAIT_L(0); PG8_MMA(0, 1, At, B1); PG8_BAR;
            PG8_LDA(At, 1, 1); PG8_STAGE(PG8_SA(1, 0), a3, voffA);
            PG8_BAR; PG8_WAIT_L(0); PG8_MMA(1, 0, At, B0); PG8_BAR; PG8_SCHED;
            PG8_STAGE(PG8_SB(1, 1), b3 + hstep, voffB);
            PG8_WAIT_V(6); PG8_BAR; PG8_MMA(1, 1, At, B1); PG8_BAR;
            }
        }
        if constexpr (ALIGN_EPI) { if (wr == 0) PG8_BAR; }
        if constexpr (!Epi::AFTER_DRAIN) { E(acc, cur, wr, wc, fr, fq); S.done(cur); }
        if (!has_next) break;
#pragma unroll
        for (int a = 0; a < 2; ++a)
#pragma unroll
            for (int b = 0; b < 2; ++b)
#pragma unroll
                for (int m = 0; m < 4; ++m)
#pragma unroll
                    for (int n = 0; n < 2; ++n) acc[a][b][m][n] = (f32x4){0.f, 0.f, 0.f, 0.f};
        cur = nxt; cA = nA; cB = nB; ++ui;
        if constexpr (ALIGN_EPI) { if (wr == 1) PG8_BAR; }
    }
    PG8_WAIT_V(0);
    if constexpr (!ALIGN_EPI) { if (wr == 0) PG8_BAR; }
    PG8_BAR;
    if constexpr (Epi::AFTER_DRAIN) { E.fused(acc, cur, wr, wc, fr, fq, lds, wid, lane); S.done(cur); }
#undef PG8_SA
#undef PG8_SB
#undef PG8_STAGE
#undef PG8_LDA
#undef PG8_LDB
#undef PG8_MMA
#undef PG8_WAIT_V
#undef PG8_WAIT_L
#undef PG8_BAR
#undef PG8_SCHED
}
}

constexpr int NWAVES = 8;
constexpr int BATCH = 2, SEQ = 8192, D = 1024, M = BATCH * SEQ, G = 256, NH = 4, HD = 64, DFF = 2816, DEPTH = 2;
constexpr int IN_COLS = 3352, NIN = 3584  , NGU = 2 * DFF;
constexpr float EPS = 1e-6f;
enum { T_AU = 0, T_AV, T_BB, T_BC, T_BH, T_CQ, T_CK, T_CV, T_CZ, T_DQ, T_DK, T_DV, T_DZ, NPT };
constexpr size_t MiB = 1u << 20;
constexpr size_t WS_CTL = 0, CTL_ZERO_BYTES = 1 * MiB;
constexpr size_t WS_SSQ1 = 1 * MiB, WS_SSQ2 = WS_SSQ1 + 256 * 1024;
constexpr size_t WS_PS = 2 * MiB;
constexpr size_t WS_W0 = 4 * MiB;
constexpr size_t WOFF_IN = 0, WOFF_OUT = 7 * MiB, WOFF_GU = 9 * MiB, WOFF_DN = 20 * MiB, W_LAYER = 26 * MiB;
constexpr size_t WS_XB = 56 * MiB;
constexpr size_t WS_MIX = 88 * MiB;
constexpr size_t WS_P = 120 * MiB;
constexpr size_t WS_TMP = 224 * MiB;
constexpr size_t WS_END = 256 * MiB;
static_assert(WS_W0 + 2 * W_LAYER <= WS_XB && WS_P + (size_t)NPT * M * 256 * 2 <= WS_TMP && (size_t)M * DFF * 2 <= WS_TMP - WS_P, "ws map");
constexpr int CW_TMO = 0, CW_CODE = 1, CW_BAR = 4096;
constexpr int RING_OFF = 0, RING_BYTES = 131072;
constexpr int LDSCTL_OFF = RING_BYTES, MISC_OFF = LDSCTL_OFF + 320;
constexpr int LDS_BYTES = 147456;

#define GAS __attribute__((address_space(1)))
#define LAS __attribute__((address_space(3)))
typedef unsigned short bf16;
typedef unsigned v4u __attribute__((ext_vector_type(4)));
typedef unsigned v2u __attribute__((ext_vector_type(2)));
typedef float f32x4 __attribute__((ext_vector_type(4)));
typedef float f32x2 __attribute__((ext_vector_type(2)));
typedef short bf16x8 __attribute__((ext_vector_type(8)));
typedef GAS unsigned gu32;
#define RLX_AGENT __ATOMIC_RELAXED, __HIP_MEMORY_SCOPE_AGENT
#define LDS_WAIT() asm volatile("s_waitcnt lgkmcnt(0)" ::: "memory")
#define VM_WAIT() asm volatile("s_waitcnt vmcnt(0)" ::: "memory")
__device__ __forceinline__ unsigned f2bf(float f) { unsigned u = __builtin_bit_cast(unsigned, f); return (u + 0x7fffu + ((u >> 16) & 1u)) >> 16; }
__device__ __forceinline__ unsigned pk2(float lo, float hi) { return f2bf(lo) | (f2bf(hi) << 16); }
__device__ __forceinline__ float bf2f(unsigned short b) { return __builtin_bit_cast(float, (unsigned)b << 16); }
__device__ __forceinline__ float bflo(unsigned w) { return __builtin_bit_cast(float, w << 16); }
__device__ __forceinline__ float bfhi(unsigned w) { return __builtin_bit_cast(float, w & 0xffff0000u); }
__device__ __forceinline__ float siluf(float x) { return x / (1.0f + __expf(-x)); }
__device__ __forceinline__ float sigmoidf(float x) { return 1.0f / (1.0f + __expf(-x)); }
__device__ __forceinline__ float softplusf(float x) { return fmaxf(x, 0.f) + log1pf(__expf(-fabsf(x))); }
__device__ __forceinline__ float geluf(float x) { const float u = 0.7978845608028654f * (x + 0.044715f * x * x * x); return 0.5f * x * (1.0f + tanhf(u)); }
__device__ __forceinline__ float wave_sum(float v) {
#pragma unroll
    for (int o = 1; o < 64; o <<= 1) v += __shfl_xor(v, o);
    return v;
}
#define XB_TMO      128
#define XB_XCNT(j)  (256  + 64 * (j))
#define XB_XSUB(j)  (1280 + 64 * (j))
#define XB_XGEN(j)  (2304 + 64 * (j))
#define XB_TOP      3328
#define XB_TOPGEN   3392
#define XCD_BAR_WORDS 3456
#define XB_SPIN_CAP (1u << 18)

__device__ __forceinline__ unsigned xb_ld(unsigned* p)              { return __hip_atomic_load(p, __ATOMIC_RELAXED, __HIP_MEMORY_SCOPE_AGENT); }
__device__ __forceinline__ unsigned xb_add(unsigned* p, unsigned v) { return __hip_atomic_fetch_add(p, v, __ATOMIC_RELAXED, __HIP_MEMORY_SCOPE_AGENT); }
__device__ __forceinline__ unsigned xb_xcc_id() { return (unsigned)__builtin_amdgcn_s_getreg((3 << 11) | 20) & 0xFu; }
#define XB_SPIN(cond, bar) do { unsigned _sp = 0; while (cond) { __builtin_amdgcn_s_sleep(1); \
    if ((++_sp & 255u) == 0u) { if (xb_ld(&(bar)[XB_TMO])) break; if (_sp > XB_SPIN_CAP) { atomicAdd(&(bar)[XB_TMO], 1u); break; } } } } while (0)

struct XcdBarrier {
    unsigned* bar; unsigned x;
    volatile LAS unsigned* st;
};

__device__ __forceinline__ XcdBarrier xcd_barrier_post(unsigned* bar, volatile LAS unsigned* st) {
    XcdBarrier b; b.bar = bar; b.x = xb_xcc_id(); b.st = st;
    if (threadIdx.x == 0) (void)xb_add(&bar[XB_XCNT(b.x)], 1u);
    return b;
}
__device__ __forceinline__ void xcd_barrier_complete(unsigned* bar, unsigned x, unsigned& nloc, unsigned& nx) {
    const unsigned G = gridDim.x * gridDim.y * gridDim.z;
    unsigned sum, cnt, mine, sp = 0u;
    for (;;) {
        sum = 0u; cnt = 0u; mine = 0u;
#pragma unroll
        for (unsigned j = 0; j < 16; ++j) { const unsigned c = xb_ld(&bar[XB_XCNT(j)]); sum += c; cnt += (c > 0u) ? 1u : 0u; mine = (j == x) ? c : mine; }
        if (sum == G) break;
        __builtin_amdgcn_s_sleep(1);
        if ((++sp & 255u) == 0u) { if (xb_ld(&bar[XB_TMO])) break; if (sp > XB_SPIN_CAP) { atomicAdd(&bar[XB_TMO], 1u); break; } }
    }
    nloc = mine > 0u ? mine : 1u; nx = cnt > 0u ? cnt : 1u;
}

__device__ __forceinline__ void xcd_barrier(const XcdBarrier& b) {
    asm volatile("s_waitcnt vmcnt(0)" ::: "memory");
    __syncthreads();
    if (threadIdx.x == 0) {
        unsigned* bar = b.bar;
        __builtin_amdgcn_s_waitcnt(0);
        unsigned nloc = b.st[0], nx = b.st[1];
        if (nloc == 0u) { xcd_barrier_complete(bar, b.x, nloc, nx); b.st[0] = nloc; b.st[1] = nx; }
        const unsigned old = xb_add(&bar[XB_XSUB(b.x)], 1u);
        const unsigned gen = old / nloc;
        if (old + 1u == (gen + 1u) * nloc) {
            __builtin_amdgcn_fence(__ATOMIC_RELEASE, "agent");
            asm volatile("s_waitcnt vmcnt(0)" ::: "memory");
            const unsigned og = xb_add(&bar[XB_TOP], 1u);
            const unsigned tg = og / nx;
            if (og + 1u == (tg + 1u) * nx) xb_add(&bar[XB_TOPGEN], 1u);
            else XB_SPIN(xb_ld(&bar[XB_TOPGEN]) == tg, bar);
            __builtin_amdgcn_fence(__ATOMIC_ACQUIRE, "agent");
            xb_add(&bar[XB_XGEN(b.x)], 1u);
            asm volatile("s_waitcnt vmcnt(0)" ::: "memory");
        } else {
            XB_SPIN(xb_ld(&bar[XB_XGEN(b.x)]) == gen, bar);
            __builtin_amdgcn_fence(__ATOMIC_ACQUIRE, "agent");
            asm volatile("s_waitcnt vmcnt(0)" ::: "memory");
        }
    }
    __syncthreads();
}

struct Args { const float* in[20]; float* out; unsigned char* ws; int ph_lo, ph_hi, li, pad; };
enum { I_X = 0, I_N1W, I_WIN, I_SLNW, I_SLNB, I_SWS, I_SBS, I_SCW, I_DCW, I_DALOG, I_DDT, I_DNW, I_GW2, I_GB, I_GNW, I_WOUT, I_N2W, I_WGU, I_WDN, I_FNW };
struct Frame {
    LAS unsigned char* lds;
    volatile LAS unsigned* MISC;
    gu32* ctl;
    int tid, lane, wave;
    int vcu, NG;
};

__device__ __forceinline__ int map_win(int d) {
    const int t = d >> 8, j = d & 255;
    if (t < 8) return d;
    if (t == 8) return 2056 + j; if (t == 9) return 2312 + j; if (t == 10) return 2568 + j; if (t == 11) return 2824 + j; if (t == 12) return 3096 + j;
    if (j < 4) return 2048 + j; if (j < 8) return 2052 + (j - 4); if (j < 24) return 3080 + (j - 8); return -1;
}
__device__ __forceinline__ int map_wgu(int d) { const int t = d >> 8, j = d & 255; return j < 128 ? 128 * t + j : DFF + 128 * t + (j - 128); }
template <int MAP> __device__ __forceinline__ void transpose_item(const float* W, int K, int N, int ND, bf16* WT, const float* kscale, LAS float* scr, int item, int lane) {
    const int nblk = ND / 32, kb = item / nblk, nb = item % nblk, k0 = 64 * kb, d0 = 32 * nb;
    const int dd = d0 + (lane & 31); const int sc = MAP == 1 ? map_win(dd) : (MAP == 2 ? map_wgu(dd) : dd);
#pragma unroll 8
    for (int i = 0; i < 32; ++i) { const int kk = 2 * i + (lane >> 5); float v = sc >= 0 ? W[(size_t)(k0 + kk) * N + sc] : 0.f; if (kscale) v *= kscale[k0 + kk]; scr[kk * 33 + (lane & 31)] = v; }
    LDS_WAIT(); asm volatile("" ::: "memory");
    const int c = lane & 7;
#pragma unroll
    for (int j = 0; j < 4; ++j) { const int n = (lane >> 3) + 8 * j; const LAS float* s = scr + (8 * c) * 33 + n;
        v4u o; o.x = pk2(s[0 * 33], s[1 * 33]); o.y = pk2(s[2 * 33], s[3 * 33]); o.z = pk2(s[4 * 33], s[5 * 33]); o.w = pk2(s[6 * 33], s[7 * 33]);
        *(GAS v4u*)(WT + (size_t)(d0 + n) * K + k0 + 8 * c) = o; }
    LDS_WAIT(); asm volatile("" ::: "memory");
}
constexpr int IT_IN = (D / 64) * (NIN / 32), IT_OUT = (D / 64) * (D / 32), IT_GU = (D / 64) * (NGU / 32), IT_DN = (DFF / 64) * (D / 32), IT_LAYER = IT_IN + IT_OUT + IT_GU + IT_DN;
typedef const __attribute__((address_space(4))) Args* KArgsP;
__device__ __forceinline__ KArgsP kargs2() { KArgsP p = (KArgsP)__builtin_amdgcn_kernarg_segment_ptr(); asm volatile("" : "+s"(p)); return p; }
__device__ __forceinline__ void convert_weights(int layer, int sel_mask, LAS float* scr, int gw, int ngw, int lane) {
#pragma unroll 1
    for (int it = gw; it < IT_LAYER; it += ngw) {
        KArgsP a = kargs2();
        unsigned char* wb = a->ws + WS_W0 + (size_t)layer * W_LAYER;
        int r = it;
        if (r < IT_IN) { if (sel_mask & 1) transpose_item<1>(a->in[I_WIN] + (size_t)layer * D * IN_COLS, D, IN_COLS, NIN, (bf16*)(wb + WOFF_IN), a->in[I_N1W] + layer * D, scr, r, lane); continue; } r -= IT_IN;
        if (r < IT_OUT) { if (sel_mask & 2) transpose_item<0>(a->in[I_WOUT] + (size_t)layer * D * D, D, D, D, (bf16*)(wb + WOFF_OUT), nullptr, scr, r, lane); continue; } r -= IT_OUT;
        if (r < IT_GU) { if (sel_mask & 4) transpose_item<2>(a->in[I_WGU] + (size_t)layer * D * NGU, D, NGU, NGU, (bf16*)(wb + WOFF_GU), a->in[I_N2W] + layer * D, scr, r, lane); continue; } r -= IT_GU;
        if (sel_mask & 8) transpose_item<0>(a->in[I_WDN] + (size_t)layer * DFF * D, DFF, D, D, (bf16*)(wb + WOFF_DN), nullptr, scr, r, lane);
    }
}
__device__ __forceinline__ void x_row_prep(const float* xrow, bf16* orow, float* ssq4, int lane) {
    const GAS f32x4* xr = (const GAS f32x4*)xrow + lane; f32x4 v[4]; float s = 0.f;
#pragma unroll
    for (int j = 0; j < 4; ++j) { v[j] = xr[64 * j]; s += (v[j].x * v[j].x + v[j].y * v[j].y) + (v[j].z * v[j].z + v[j].w * v[j].w); }
    s = wave_sum(s);
    GAS unsigned long long* o8 = (GAS unsigned long long*)orow + lane;
#pragma unroll
    for (int j = 0; j < 4; ++j) o8[64 * j] = (unsigned long long)pk2(v[j].x, v[j].y) | ((unsigned long long)pk2(v[j].z, v[j].w) << 32);
    if (lane == 0) *(f32x4*)ssq4 = (f32x4){s, 0.f, 0.f, 0.f};
}
__device__ __forceinline__ void final_row(float* row, const float* ssq4, const float* fw, int lane) {
    const f32x4 s = *(const f32x4*)ssq4; const float rs = rsqrtf(((s[0] + s[1]) + (s[2] + s[3])) * (1.0f / D) + EPS);
    GAS f32x4* xr = (GAS f32x4*)row + lane; const GAS f32x4* wr = (const GAS f32x4*)fw + lane;
#pragma unroll
    for (int j = 0; j < 4; ++j) { const f32x4 v = xr[64 * j], w = wr[64 * j]; xr[64 * j] = v * rs * w; }
}

__device__ __forceinline__ void s_sgu_ln_row(const bf16* Pav, const float* lnw, const float* lnb, float* VT, int row, int lane) {
    const v2u w = *(const v2u*)(Pav + (size_t)row * 256 + 4 * lane);
    float v[4] = {geluf(bflo(w.x)), geluf(bfhi(w.x)), geluf(bflo(w.y)), geluf(bfhi(w.y))};
    const float mu = wave_sum((v[0] + v[1]) + (v[2] + v[3])) * (1.0f / 256.0f);
    float q = 0.f;
#pragma unroll
    for (int i = 0; i < 4; ++i) { v[i] -= mu; q += v[i] * v[i]; }
    const float rstd = rsqrtf(wave_sum(q) * (1.0f / 256.0f) + EPS);
#pragma unroll
    for (int i = 0; i < 4; ++i) VT[(size_t)row * 256 + 4 * lane + i] = v[i] * rstd * lnw[4 * lane + i] + lnb[4 * lane + i];
}
__device__ __forceinline__ void s_sgu_mix(const bf16* Pau, const float* VT, const float* Wsp, const float* bsp, bf16* MIX, int t, int c) {
    const int tt = t & 127, base = t - tt, h = c >> 6;
    const float* wrow = Wsp + ((size_t)h * 128 + tt) * 128; float acc = 0.f;
    for (int s = 0; s <= tt; ++s) acc += wrow[s] * VT[(size_t)(base + s) * 256 + c];
    const float u = geluf(bf2f(Pau[(size_t)t * 256 + c]));
    MIX[(size_t)t * D + c] = (bf16)f2bf(u * (acc + bsp[h * 128 + tt]));
}
__device__ __forceinline__ void s_shortconv(const bf16* Pbb, const bf16* Pbc, const bf16* Pbh, const float* cw, bf16* MIX, int t, int c) {
    const int tb = t & (SEQ - 1); float y = 0.f;
#pragma unroll
    for (int k = 0; k < 3; ++k) { const int o = k - 2; if (tb + o >= 0) y += cw[k * 256 + c] * (bf2f(Pbc[(size_t)(t + o) * 256 + c]) * bf2f(Pbh[(size_t)(t + o) * 256 + c])); }
    MIX[(size_t)t * D + 256 + c] = (bf16)f2bf(bf2f(Pbb[(size_t)t * 256 + c]) * y);
}
__device__ __forceinline__ void s_scan(const bf16* P, const float* PS, const float* dcw, const float* alog, const float* dtb, const float* dnw,
                                       const float* gw2, const float* gb, const float* gnw, bf16* MIX, LAS float* sm, int item, int lane) {
    LAS float* sq = sm; LAS float* sk = sm + 4096; LAS float* sv = sm + 8192; LAS float* sa = sm + 12288; LAS float* salpha = sm + 16384; LAS float* sbeta = sm + 16448;
    const int isg = item >> 3, bh = item & 7, b = bh >> 2, h = bh & 3, ch = h * 64 + lane;
    float S[64];
#pragma unroll
    for (int d = 0; d < 64; ++d) S[d] = 0.f;
    const bf16 *Pq = P + (size_t)(isg ? T_DQ : T_CQ) * M * 256, *Pk = P + (size_t)(isg ? T_DK : T_CK) * M * 256, *Pv = P + (size_t)(isg ? T_DV : T_CV) * M * 256, *Pz = P + (size_t)(isg ? T_DZ : T_CZ) * M * 256;
    const float nw = isg ? gnw[lane] : dnw[lane];
    LAS float* w2 = sm + 16512 + lane; LAS float* cq = sm + 16512 + 1024 + lane; LAS float* ck = cq + 256; LAS float* cv = ck + 256;
#pragma unroll
    for (int r = 0; r < 16; ++r) w2[r * 64] = gw2[r * 256 + ch];
    const float gbias = gb[ch], A = __expf(alog[h]), dt = dtb[h];
#pragma unroll
    for (int j = 0; j < 4; ++j) { cq[j * 64] = dcw[j * 768 + ch]; ck[j * 64] = dcw[j * 768 + 256 + ch]; cv[j * 64] = dcw[j * 768 + 512 + ch]; }
#pragma unroll 1
    for (int n = 0; n < SEQ / 64; ++n) {
        const int t0 = b * SEQ + n * 64;
        LDS_WAIT(); asm volatile("" ::: "memory");
#pragma unroll 2
        for (int tok = 0; tok < 64; ++tok) {
            const int t = t0 + tok;
            if (!isg) {
                float q = 0.f, k = 0.f, v = 0.f;
#pragma unroll
                for (int j = 0; j < 4; ++j) { const int o = j - 3; if (n * 64 + tok + o >= 0) { const size_t a = (size_t)(t + o) * 256 + ch; q += cq[j * 64] * bf2f(Pq[a]); k += ck[j * 64] * bf2f(Pk[a]); v += cv[j * 64] * bf2f(Pv[a]); } }
                q = siluf(q); k = siluf(k); v = siluf(v);
                q *= rsqrtf(wave_sum(q * q) + EPS) * 0.125f; k *= rsqrtf(wave_sum(k * k) + EPS);
                sq[tok * 64 + lane] = q; sk[tok * 64 + lane] = k; sv[tok * 64 + lane] = v;
                if (lane == 0) { salpha[tok] = __expf(-A * softplusf(PS[(size_t)t * 32 + h] + dt)); sbeta[tok] = sigmoidf(PS[(size_t)t * 32 + 4 + h]); }
            } else {
                const size_t a = (size_t)t * 256 + ch;
                sq[tok * 64 + lane] = bf2f(Pq[a]) * 0.125f; sk[tok * 64 + lane] = bf2f(Pk[a]); sv[tok * 64 + lane] = bf2f(Pv[a]);
                float pre = gbias;
#pragma unroll
                for (int r = 0; r < 16; ++r) pre += PS[(size_t)t * 32 + 8 + r] * w2[r * 64];
                sa[tok * 64 + lane] = __expf(-softplusf(-pre) * (1.0f / 16.0f));
            }
        }
        LDS_WAIT(); asm volatile("" ::: "memory");
#pragma unroll 1
        for (int tok = 0; tok < 64; ++tok) {
            const int t = t0 + tok; float o = 0.f;
            if (!isg) {
                const float alpha = salpha[tok], beta = sbeta[tok]; float kS = 0.f;
#pragma unroll
                for (int d = 0; d < 64; ++d) kS += sk[tok * 64 + d] * S[d];
                const float vn = beta * (sv[tok * 64 + lane] - alpha * kS);
#pragma unroll
                for (int d = 0; d < 64; ++d) { S[d] = alpha * S[d] + sk[tok * 64 + d] * vn; o += sq[tok * 64 + d] * S[d]; }
            } else {
                const float ve = sv[tok * 64 + lane];
#pragma unroll
                for (int d = 0; d < 64; ++d) { S[d] = sa[tok * 64 + d] * S[d] + sk[tok * 64 + d] * ve; o += sq[tok * 64 + d] * S[d]; }
            }
            const float ms = wave_sum(o * o) * (1.0f / 64.0f);
            const float y = o * rsqrtf(ms + EPS) * nw * siluf(bf2f(Pz[(size_t)t * 256 + ch]));
            MIX[(size_t)t * D + (isg ? 768 : 512) + ch] = (bf16)f2bf(y);
        }
    }
}

constexpr int PH_PRO = 0, PH_PER_LAYER = 7, PH_FINAL = 1 + DEPTH * PH_PER_LAYER, N_PHASES = PH_FINAL + 1;
typedef const __attribute__((address_space(4))) Args* KArgs;
__device__ __forceinline__ KArgs kargs() { KArgs p = (KArgs)__builtin_amdgcn_kernarg_segment_ptr(); asm volatile("" : "+s"(p)); return p; }
__global__ void __launch_bounds__(NWAVES * 64, 2) mk_fwd(Args args_unused) {
    extern __shared__ __attribute__((aligned(16))) unsigned char lds[];
    Frame F;
    F.lds = (LAS unsigned char*)lds;
    F.MISC = (volatile LAS unsigned*)(F.lds + MISC_OFF);
    F.tid = threadIdx.x; F.lane = F.tid & 63; F.wave = __builtin_amdgcn_readfirstlane(F.tid >> 6);
    F.NG = gridDim.x; { const int bx = blockIdx.x; F.vcu = (F.NG % 8 == 0) ? (bx % 8) * (F.NG / 8) + bx / 8 : bx; }
    for (int u = F.tid; u < (LDS_BYTES - LDSCTL_OFF) / 4; u += NWAVES * 64) ((LAS unsigned*)(F.lds + LDSCTL_OFF))[u] = 0u;
    __syncthreads();
    int lo, hi; { KArgs a = kargs(); lo = a->ph_lo; hi = a->ph_hi; F.ctl = (gu32*)(a->ws + WS_CTL); }
    XcdBarrier bar; bar.bar = (unsigned*)(F.ctl + CW_BAR); bar.x = 0; bar.st = nullptr;
    if (hi - lo > 1) bar = xcd_barrier_post((unsigned*)(F.ctl + CW_BAR), F.MISC + 8);
#pragma unroll 1
    for (int ph = lo; ph < hi; ++ph) {
        KArgs a = kargs();
        int NG = F.NG, bx = blockIdx.x, vcu = F.vcu, wv = F.wave; asm volatile("" : "+s"(NG), "+s"(bx), "+s"(vcu), "+s"(wv));
        int lane_l = F.lane; asm volatile("" : "+v"(lane_l));
        const int gw = vcu * NWAVES + wv, ngw = NG * NWAVES;
        unsigned char* const ws = a->ws;
        if (ph == PH_PRO) {
            LAS float* scr = (LAS float*)(F.lds + RING_OFF + wv * 16384);
#pragma unroll 1
            for (int l = 0; l < DEPTH; ++l) convert_weights(l, 15, scr, gw, ngw, lane_l);
            const float* x = a->in[I_X];
#pragma unroll 1
            for (int m = gw; m < M; m += ngw) x_row_prep(x + (size_t)m * D, (bf16*)(ws + WS_XB) + (size_t)m * D, (float*)(ws + WS_SSQ2) + (size_t)m * 4, lane_l);
        } else if (ph == PH_FINAL) {
            float* xres = a->out; const float* fw = a->in[I_FNW];
#pragma unroll 1
            for (int m = gw; m < M; m += ngw) final_row(xres + (size_t)m * D, (float*)(ws + WS_SSQ2) + (size_t)m * 4, fw, lane_l);
        } else {
            const int l = (ph - 1) / PH_PER_LAYER, sub = (ph - 1) % PH_PER_LAYER;
            unsigned char* wb = ws + WS_W0 + (size_t)l * W_LAYER;
            if (sub == 0) {
                pg8::Gemm g{(const bf16*)(ws + WS_XB), (const bf16*)(wb + WOFF_IN), M, NIN, D}; pg8::StaticOrder S; S.init(M, NIN, NG, bx);
                pg8::EpiIn E{(bf16*)(ws + WS_P), (float*)(ws + WS_PS), (const float*)(ws + WS_SSQ2)};
                pg8::gemm_phase<pg8::EpiIn, pg8::StaticOrder, true, true>(F.lds + RING_OFF, g, S, E);
            } else if (sub == 4 || sub == 6) {
                const bool dn = (sub == 6);
                pg8::Gemm g{(const bf16*)(ws + (dn ? WS_P : WS_MIX)), (const bf16*)(wb + (dn ? WOFF_DN : WOFF_OUT)), M, D, dn ? DFF : D}; pg8::StaticOrder S; S.init(M, D, NG, bx);
                float* xres = a->out;
                pg8::EpiRes E{(!dn && l == 0) ? a->in[I_X] : xres, xres, (bf16*)(ws + WS_XB), (float*)(ws + (dn ? WS_SSQ2 : WS_SSQ1))};
                if (NG == 256) pg8::gemm_phase<pg8::EpiRes, pg8::StaticOrder, false, true>(F.lds + RING_OFF, g, S, E);
            } else if (sub == 5) {
                pg8::Gemm g{(const bf16*)(ws + WS_XB), (const bf16*)(wb + WOFF_GU), M, NGU, D}; pg8::StaticOrder S; S.init(M, NGU, NG, bx);
                pg8::EpiGU E{(bf16*)(ws + WS_P), (const float*)(ws + WS_SSQ1)};
                pg8::gemm_phase<pg8::EpiGU, pg8::StaticOrder, true, true>(F.lds + RING_OFF, g, S, E);
            } else if (sub == 1) {
                const bf16* P = (const bf16*)(ws + WS_P); bf16* MIX = (bf16*)(ws + WS_MIX); float* VT = (float*)(ws + WS_TMP);
                const float* lnw = a->in[I_SLNW] + l * 256; const float* lnb = a->in[I_SLNB] + l * 256; const float* scw = a->in[I_SCW] + l * 3 * 256;
#pragma unroll 1
                for (int m = gw; m < M; m += ngw) s_sgu_ln_row(P + (size_t)T_AV * M * 256, lnw, lnb, VT, m, lane_l);
#pragma unroll 1
                for (int i = gw; i < M * 4; i += ngw) s_shortconv(P + (size_t)T_BB * M * 256, P + (size_t)T_BC * M * 256, P + (size_t)T_BH * M * 256, scw, MIX, i >> 2, (i & 3) * 64 + lane_l);
            } else if (sub == 2) {
                const bf16* P = (const bf16*)(ws + WS_P); bf16* MIX = (bf16*)(ws + WS_MIX); const float* VT = (const float*)(ws + WS_TMP);
                if (bx < 16) {
                    if (wv == 0) s_scan(P, (const float*)(ws + WS_PS), a->in[I_DCW] + l * 4 * 768, a->in[I_DALOG] + l * 4, a->in[I_DDT] + l * 4, a->in[I_DNW] + l * 64,
                                        a->in[I_GW2] + l * 16 * 256, a->in[I_GB] + l * 256, a->in[I_GNW] + l * 64, MIX, (LAS float*)(F.lds + RING_OFF), bx, lane_l);
                } else {
                    const float* wsp = a->in[I_SWS] + (size_t)l * 4 * 128 * 128; const float* bsp = a->in[I_SBS] + l * 4 * 128;
                    const int gw2 = (bx - 16) * NWAVES + wv, ngw2 = (NG - 16) * NWAVES;
#pragma unroll 1
                    for (int i = gw2; i < M * 4; i += ngw2) s_sgu_mix(P + (size_t)T_AU * M * 256, VT, wsp, bsp, MIX, i >> 2, (i & 3) * 64 + lane_l);
                }
            } else {
            }
        }
        if (ph + 1 < hi) xcd_barrier(bar);
    }
}

extern "C" void kernel_launch(void* const* d_in, const int* in_sizes, int n_in, void* d_out, int out_size, void* d_ws, size_t ws_size, hipStream_t stream) {
    static int grid = 0;
    if (grid == 0) {
        if (n_in != 20 || in_sizes[0] != M * D || out_size != M * D || ws_size < WS_END) { fprintf(stderr, "kernel_launch: unexpected shapes (n_in %d in0 %d out %d ws %zu)\n", n_in, n_in > 0 ? in_sizes[0] : -1, out_size, ws_size); grid = -1; return; }
        int dev = 0, cus = 0;
        if (hipGetDevice(&dev) != hipSuccess || hipDeviceGetAttribute(&cus, hipDeviceAttributeMultiprocessorCount, dev) != hipSuccess) { grid = -1; return; }
        if (hipFuncSetAttribute((const void*)mk_fwd, hipFuncAttributeMaxDynamicSharedMemorySize, LDS_BYTES) != hipSuccess) { fprintf(stderr, "kernel_launch: hipFuncSetAttribute failed\n"); grid = -1; return; }
        (void)hipGetLastError();
        grid = cus;
        if (grid != 256) fprintf(stderr, "kernel_launch: %d CUs, expected 256\n", grid);
    }
    if (grid < 0) return;
    (void)hipMemsetAsync((char*)d_ws + WS_CTL, 0, CTL_ZERO_BYTES, stream);
    Args a{};
    for (int i = 0; i < 20; ++i) a.in[i] = (const float*)d_in[i];
    a.out = (float*)d_out; a.ws = (unsigned char*)d_ws;
    a.ph_lo = 0; a.ph_hi = N_PHASES; a.li = 0;
    hipLaunchKernelGGL(mk_fwd, dim3(grid), dim3(NWAVES * 64), LDS_BYTES, stream, a);
}
```

```cpp
#include <hip/hip_runtime.h>
#include <cstdio>
#include <cstdint>
namespace pg8 {
#define PG8_LAS __attribute__((address_space(3)))
typedef unsigned short bf16_t;
typedef short bf16x8 __attribute__((ext_vector_type(8)));
typedef float f32x4 __attribute__((ext_vector_type(4)));
typedef unsigned u32x4 __attribute__((ext_vector_type(4)));
typedef unsigned u32x2 __attribute__((ext_vector_type(2)));
constexpr int BM = 256, BK = 64, HALF = 128, HTB = HALF * BK * 2  , STAGE_BYTES = 8 * HTB, NXCD = 8, WGM = 8;

__host__ __device__ __forceinline__ int lds_byte(int r, int c) { const int st = (r >> 4) * 2 + (c >> 5), rr = r & 15, cc = c & 31, ob = rr * 64 + cc * 2; return st * 1024 + (ob ^ (((ob >> 9) & 1) << 5)); }
__host__ __device__ __forceinline__ void stage_rc(int b, int& R, int& C) { const int st = b / 1024, sb = b % 1024, swz = sb ^ (((sb >> 9) & 1) << 5); R = (st >> 1) * 16 + swz / 64; C = (st & 1) * 32 + (swz % 64) / 2; }
__host__ __device__ __forceinline__ int perm32(int rho) { const int n = rho >> 4, i = rho & 15; return 8 * (i >> 2) + 4 * n + (i & 3); }

struct Unit { int pm, pn; };
struct Gemm { const bf16_t* A; const bf16_t* Bt; int M, N, K; };

struct StaticOrder {
    int nM, nN, nwg, G, c;
    __host__ __device__ void init(int M, int N, int G_, int c_) { nM = M / BM; nN = N / BM; nwg = nM * nN; G = G_; c = c_; }
    __host__ __device__ bool next(int i, Unit& u) const {
        const long L = (long)i * G + c; if (L >= nwg) return false;
        int wgid = (int)L; { const int q = nwg / NXCD, r = nwg % NXCD, xcd = wgid % NXCD, off = wgid / NXCD; wgid = (xcd < r ? xcd * (q + 1) : r * (q + 1) + (xcd - r) * q) + off; }
        const int nig = WGM * nN, gid = wgid / nig, fm = gid * WGM, gsz = (nM - fm) < WGM ? (nM - fm) : WGM;
        u.pm = fm + ((wgid % nig) % gsz); u.pn = (wgid % nig) / gsz; return true;
    }
    __device__ __forceinline__ void a_ready(const Unit&) const {}
    __device__ __forceinline__ void done(const Unit&) const {}
};

__device__ __forceinline__ unsigned cvt_pk_bf16(float lo, float hi) { unsigned r; asm volatile("v_cvt_pk_bf16_f32 %0, %1, %2" : "=v"(r) : "v"(lo), "v"(hi)); return r; }
constexpr int TOK = 16384;
constexpr float NEPS = 1e-6f;
__device__ __forceinline__ float row_rstd(const float* ssq, int row) { const f32x4 s = *(const f32x4*)(ssq + (size_t)row * 4); return rsqrtf(((s[0] + s[1]) + (s[2] + s[3])) * (1.0f / 1024.0f) + NEPS); }

struct EpiIn {
    static constexpr bool PERM = true, AFTER_DRAIN = false;
    bf16_t* P; float* PS; const float* ssq;
    __device__ __forceinline__ void operator()(const f32x4 (&acc)[2][2][4][2], const Unit& u, int wr, int wc, int fr, int fq) const {
        const int row0 = u.pm * BM + wr * 64 + fr;
#pragma unroll
        for (int ai = 0; ai < 2; ++ai)
#pragma unroll
            for (int m = 0; m < 4; ++m) {
                const int row = row0 + ai * HALF + m * 16; const float rs = row_rstd(ssq, row);
                if (u.pn < 13) {
                    bf16_t* rowp = P + (size_t)u.pn * TOK * 256 + (size_t)row * 256 + wc * 32 + 8 * fq;
#pragma unroll
                    for (int bj = 0; bj < 2; ++bj) { const f32x4 v0 = acc[ai][bj][m][0] * rs, v1 = acc[ai][bj][m][1] * rs; u32x4 w;
                        w.x = cvt_pk_bf16(v0[0], v0[1]); w.y = cvt_pk_bf16(v0[2], v0[3]); w.z = cvt_pk_bf16(v1[0], v1[1]); w.w = cvt_pk_bf16(v1[2], v1[3]);
                        *(u32x4*)(rowp + bj * HALF) = w; }
                } else if (wc == 0) {
                    float* rp = PS + (size_t)row * 32 + 8 * fq;
                    *(f32x4*)rp = acc[ai][0][m][0] * rs; *(f32x4*)(rp + 4) = acc[ai][0][m][1] * rs;
                }
            }
    }
};
struct EpiGU {
    static constexpr bool PERM = true, AFTER_DRAIN = false;
    bf16_t* H; const float* ssq;
    __device__ __forceinline__ void operator()(const f32x4 (&acc)[2][2][4][2], const Unit& u, int wr, int wc, int fr, int fq) const {
        const int row0 = u.pm * BM + wr * 64 + fr;
#pragma unroll
        for (int ai = 0; ai < 2; ++ai)
#pragma unroll
            for (int m = 0; m < 4; ++m) {
                const int row = row0 + ai * HALF + m * 16; const float rs = row_rstd(ssq, row);
                float h[8];
#pragma unroll
                for (int n = 0; n < 2; ++n)
#pragma unroll
                    for (int i = 0; i < 4; ++i) { const float g = acc[ai][0][m][n][i] * rs, up = acc[ai][1][m][n][i] * rs; h[n * 4 + i] = g * up * __builtin_amdgcn_rcpf(1.0f + __expf(-g)); }
                u32x4 w; w.x = cvt_pk_bf16(h[0], h[1]); w.y = cvt_pk_bf16(h[2], h[3]); w.z = cvt_pk_bf16(h[4], h[5]); w.w = cvt_pk_bf16(h[6], h[7]);
                *(u32x4*)(H + (size_t)row * 2816 + u.pn * 128 + wc * 32 + 8 * fq) = w;
            }
    }
};
struct EpiRes {
    static constexpr bool PERM = false, AFTER_DRAIN = true;
    const float* xin; float* xout; bf16_t* xb; float* ssq;
    __device__ __forceinline__ void operator()(const f32x4 (&)[2][2][4][2], const Unit&, int, int, int, int) const {}
    __device__ __forceinline__ void fused(f32x4 (&acc)[2][2][4][2], const Unit& u, int wr, int wc, int fr, int fq, PG8_LAS unsigned char* lds, int wid, int lane) const {
        PG8_LAS float* part = (PG8_LAS float*)lds;
        const int col0 = u.pn * BM + wc * 32 + 4 * fq;
#pragma unroll
        for (int ai = 0; ai < 2; ++ai)
#pragma unroll
            for (int m = 0; m < 4; ++m) {
                const int r = ai * HALF + wr * 64 + m * 16 + fr; const size_t off = (size_t)(u.pm * BM + r) * 1024 + col0; float s = 0.f;
#pragma unroll
                for (int bj = 0; bj < 2; ++bj)
#pragma unroll
                    for (int n = 0; n < 2; ++n) { const f32x4 xo = *(const f32x4*)(xin + off + bj * HALF + n * 16); const f32x4 xn = xo + acc[ai][bj][m][n];
                        *(f32x4*)(xout + off + bj * HALF + n * 16) = xn; s += (xn[0] * xn[0] + xn[1] * xn[1]) + (xn[2] * xn[2] + xn[3] * xn[3]);
                        u32x2 w; w.x = cvt_pk_bf16(xn[0], xn[1]); w.y = cvt_pk_bf16(xn[2], xn[3]); *(u32x2*)(xb + off + bj * HALF + n * 16) = w; }
                s += __shfl_xor(s, 16); s += __shfl_xor(s, 32);
                if (fq == 0) part[r * 4 + wc] = s;
            }
        asm volatile("s_waitcnt lgkmcnt(0)" ::: "memory"); __builtin_amdgcn_s_barrier(); asm volatile("" ::: "memory");
        const int t = wid * 64 + lane;
        if (t < 256) { const f32x4 p = *(const PG8_LAS f32x4*)(part + t * 4); ssq[(size_t)(u.pm * BM + t) * 4 + u.pn] = (p[0] + p[1]) + (p[2] + p[3]); }
        asm volatile("s_waitcnt lgkmcnt(0)" ::: "memory"); __builtin_amdgcn_s_barrier(); asm volatile("" ::: "memory");
    }
};

template <class Epi, class Sched, bool ALIGN_EPI = false, bool SP2 = false>
__device__ __forceinline__ void gemm_phase(PG8_LAS unsigned char* lds, const Gemm g, const Sched& S, const Epi& E) {
    int tid_ = threadIdx.x; asm volatile("" : "+v"(tid_));
    const int tid = tid_, wid = __builtin_amdgcn_readfirstlane(tid >> 6), lane = tid & 63, wr = wid >> 2, wc = wid & 3, fr = lane & 15, fq = lane >> 4;
    const int K = g.K, nt = K / BK;
    unsigned voffA[2], voffB[2];
#pragma unroll
    for (int i = 0; i < 2; ++i) { int R, C; stage_rc(tid * 16 + i * 8192, R, C); const int Rb = Epi::PERM ? ((R & ~31) + perm32(R & 31)) : R;
        voffA[i] = (unsigned)(R * K + C) * 2u; voffB[i] = (unsigned)(Rb * K + C) * 2u; }
    const size_t kstep = (size_t)(BK * 2);
    const size_t hstep = (size_t)HALF * K * 2;
    const size_t tstep = 2 * hstep;
    const unsigned ldsw = (unsigned)wid * 1024u;
    const int aoff = lds_byte(wr * 64 + fr, fq * 8), boff = lds_byte(wc * 32 + fr, fq * 8);
#define PG8_SA(b, h) (((b) * 2 + (h)) * HTB)
#define PG8_SB(b, h) ((4 + (b) * 2 + (h)) * HTB)
#define PG8_STAGE(bufoff, gbase, voff) do { _Pragma("unroll") for (int _i = 0; _i < 2; ++_i) \
        __builtin_amdgcn_global_load_lds((const unsigned*)((const char*)(gbase) + (voff)[_i]), (PG8_LAS unsigned*)(lds + (bufoff) + ldsw + _i * 8192), 16, 0, 0); } while (0)
#define PG8_LDA(dst, b, h) do { _Pragma("unroll") for (int m = 0; m < 4; ++m) _Pragma("unroll") for (int k = 0; k < 2; ++k) dst[m][k] = *(const PG8_LAS bf16x8*)(lds + PG8_SA(b, h) + aoff + m * 2048 + k * 1024); } while (0)
#define PG8_LDB(dst, b, h) do { _Pragma("unroll") for (int n = 0; n < 2; ++n) _Pragma("unroll") for (int k = 0; k < 2; ++k) dst[n][k] = *(const PG8_LAS bf16x8*)(lds + PG8_SB(b, h) + boff + n * 2048 + k * 1024); } while (0)
#define PG8_MMA(ai, bj, At, Bt) do { __builtin_amdgcn_s_setprio(1); _Pragma("unroll") for (int m = 0; m < 4; ++m) _Pragma("unroll") for (int n = 0; n < 2; ++n) _Pragma("unroll") for (int k = 0; k < 2; ++k) \
        acc[ai][bj][m][n] = __builtin_amdgcn_mfma_f32_16x16x32_bf16(Bt[n][k], At[m][k], acc[ai][bj][m][n], 0, 0, 0); __builtin_amdgcn_s_setprio(0); } while (0)
#define PG8_WAIT_V(n) asm volatile("s_waitcnt vmcnt(" #n ")" ::: "memory")
#define PG8_WAIT_L(n) asm volatile("s_waitcnt lgkmcnt(" #n ")" ::: "memory")
#define PG8_BAR __builtin_amdgcn_s_barrier()
#define PG8_SCHED __builtin_amdgcn_sched_barrier(0)
    Unit cur, nxt; int ui = 0;
    if (!S.next(0, cur)) return;
    f32x4 acc[2][2][4][2];
#pragma unroll
    for (int a = 0; a < 2; ++a)
#pragma unroll
        for (int b = 0; b < 2; ++b)
#pragma unroll
            for (int m = 0; m < 4; ++m)
#pragma unroll
                for (int n = 0; n < 2; ++n) acc[a][b][m][n] = (f32x4){0.f, 0.f, 0.f, 0.f};
    bf16x8 At[4][2], B0[2][2], B1[2][2];
    const char* cA = (const char*)g.A + (size_t)cur.pm * tstep; const char* cB = (const char*)g.Bt + (size_t)cur.pn * tstep;
    S.a_ready(cur);
    if constexpr (SP2) {
        PG8_STAGE(PG8_SB(0, 0), cB, voffB); PG8_STAGE(PG8_SB(0, 1), cB + hstep, voffB); PG8_STAGE(PG8_SA(0, 0), cA, voffA); PG8_STAGE(PG8_SA(0, 1), cA + hstep, voffA);
        if (wr == 1) PG8_BAR;
        PG8_WAIT_V(2); PG8_BAR;
        PG8_STAGE(PG8_SB(1, 0), cB + kstep, voffB); PG8_STAGE(PG8_SA(1, 0), cA + kstep, voffA); PG8_STAGE(PG8_SB(1, 1), cB + hstep + kstep, voffB);
        PG8_WAIT_V(6); PG8_BAR;
    } else {
        PG8_STAGE(PG8_SB(0, 0), cB, voffB); PG8_STAGE(PG8_SA(0, 0), cA, voffA); PG8_STAGE(PG8_SB(0, 1), cB + hstep, voffB); PG8_STAGE(PG8_SA(0, 1), cA + hstep, voffA);
        if (wr == 1) PG8_BAR;
        PG8_WAIT_V(4); PG8_BAR;
        PG8_STAGE(PG8_SB(1, 0), cB + kstep, voffB); PG8_STAGE(PG8_SA(1, 0), cA + kstep, voffA); PG8_STAGE(PG8_SB(1, 1), cB + hstep + kstep, voffB);
        PG8_WAIT_V(6); PG8_BAR;
    }
    for (;;) {
        const bool has_next = S.next(ui + 1, nxt);
        const char* nA = has_next ? (const char*)g.A + (size_t)nxt.pm * tstep : cA; const char* nB = has_next ? (const char*)g.Bt + (size_t)nxt.pn * tstep : cB;
        for (int t = 0; t < nt; t += 2) {
            const bool last = (t == nt - 2);
            const char* a1 = cA + (size_t)(t + 1) * kstep;
            const char* a2 = last ? nA : cA + (size_t)(t + 2) * kstep; const char* b2 = last ? nB : cB + (size_t)(t + 2) * kstep;
            const char* a3 = a2 + kstep; const char* b3 = b2 + kstep;
            if (last && has_next) S.a_ready(nxt);
            if constexpr (SP2) {
            PG8_LDB(B0, 0, 0); PG8_LDB(B1, 0, 1); PG8_SCHED; PG8_LDA(At, 0, 0); PG8_STAGE(PG8_SA(1, 1), a1 + hstep, voffA);
            PG8_WAIT_V(8); PG8_WAIT_L(0); PG8_BAR; PG8_MMA(0, 0, At, B0); PG8_MMA(0, 1, At, B1); PG8_BAR; PG8_SCHED;
            PG8_LDA(At, 0, 1); PG8_STAGE(PG8_SB(0, 0), b2, voffB); PG8_STAGE(PG8_SB(0, 1), b2 + hstep, voffB); PG8_STAGE(PG8_SA(0, 0), a2, voffA);
            PG8_WAIT_V(8); PG8_WAIT_L(0); PG8_BAR; PG8_MMA(1, 0, At, B0); PG8_MMA(1, 1, At, B1); PG8_BAR; PG8_SCHED;
            PG8_LDB(B0, 1, 0); PG8_LDB(B1, 1, 1); PG8_SCHED; PG8_LDA(At, 1, 0); PG8_STAGE(PG8_SA(0, 1), a2 + hstep, voffA);
            PG8_WAIT_V(8); PG8_WAIT_L(0); PG8_BAR; PG8_MMA(0, 0, At, B0); PG8_MMA(0, 1, At, B1); PG8_BAR; PG8_SCHED;
            PG8_LDA(At, 1, 1); PG8_STAGE(PG8_SB(1, 0), b3, voffB); PG8_STAGE(PG8_SB(1, 1), b3 + hstep, voffB); PG8_STAGE(PG8_SA(1, 0), a3, voffA);
            PG8_WAIT_V(8); PG8_WAIT_L(0); PG8_BAR; PG8_MMA(1, 0, At, B0); PG8_MMA(1, 1, At, B1); PG8_BAR; PG8_SCHED;
            } else {
            PG8_LDB(B0, 0, 0); PG8_SCHED; PG8_LDA(At, 0, 0); PG8_STAGE(PG8_SA(1, 1), a1 + hstep, voffA);
            PG8_WAIT_L(8); PG8_BAR; PG8_WAIT_L(0); PG8_MMA(0, 0, At, B0); PG8_BAR; PG8_SCHED;
            PG8_LDB(B1, 0, 1); PG8_STAGE(PG8_SB(0, 0), b2, voffB);
            PG8_BAR; PG8_WAIT_L(0); PG8_MMA(0, 1, At, B1); PG8_BAR;
            PG8_LDA(At, 0, 1); PG8_STAGE(PG8_SA(0, 0), a2, voffA);
            PG8_BAR; PG8_WAIT_L(0); PG8_MMA(1, 0, At, B0); PG8_BAR; PG8_SCHED;
            PG8_STAGE(PG8_SB(0, 1), b2 + hstep, voffB);
            PG8_WAIT_V(6); PG8_BAR; PG8_MMA(1, 1, At, B1); PG8_BAR;
            PG8_LDB(B0, 1, 0); PG8_SCHED; PG8_LDA(At, 1, 0); PG8_STAGE(PG8_SA(0, 1), a2 + hstep, voffA);
            PG8_WAIT_L(8); PG8_BAR; PG8_WAIT_L(0); PG8_MMA(0, 0, At, B0); PG8_BAR; PG8_SCHED;
            PG8_LDB(B1, 1, 1); PG8_STAGE(PG8_SB(1, 0), b3, voffB);
            PG8_BAR; PG8_WAIT_L(0); PG8_MMA(0, 1, At, B1); PG8_BAR;
            PG8_LDA(At, 1, 1); PG8_STAGE(PG8_SA(1, 0), a3, voffA);
            PG8_BAR; PG8_WAIT_L(0); PG8_MMA(1, 0, At, B0); PG8_BAR; PG8_SCHED;
            PG8_STAGE(PG8_SB(1, 1), b3 + hstep, voffB);
            PG8_WAIT_V(6); PG8_BAR; PG8_MMA(1, 1, At, B1); PG8_BAR;
            }
        }
        if constexpr (ALIGN_EPI) { if (wr == 0) PG8_BAR; }
        if constexpr (!Epi::AFTER_DRAIN) { E(acc, cur, wr, wc, fr, fq); S.done(cur); }
        if (!has_next) break;
#pragma unroll
        for (int a = 0; a < 2; ++a)
#pragma unroll
            for (int b = 0; b < 2; ++b)
#pragma unroll
                for (int m = 0; m < 4; ++m)
#pragma unroll
                    for (int n = 0; n < 2; ++n) acc[a][b][m][n] = (f32x4){0.f, 0.f, 0.f, 0.f};
        cur = nxt; cA = nA; cB = nB; ++ui;
        if constexpr (ALIGN_EPI) { if (wr == 1) PG8_BAR; }
    }
    PG8_WAIT_V(0);
    if constexpr (!ALIGN_EPI) { if (wr == 0) PG8_BAR; }
    PG8_BAR;
    if constexpr (Epi::AFTER_DRAIN) { E.fused(acc, cur, wr, wc, fr, fq, lds, wid, lane); S.done(cur); }
#undef PG8_SA
#undef PG8_SB
#undef PG8_STAGE
#undef PG8_LDA
#undef PG8_LDB
#undef PG8_MMA
#undef PG8_WAIT_V
#undef PG8_WAIT_L
#undef PG8_BAR
#undef PG8_SCHED
}
}

constexpr int NWAVES = 8;
constexpr int BATCH = 2, SEQ = 8192, D = 1024, M = BATCH * SEQ, G = 256, NH = 4, HD = 64, DFF = 2816, DEPTH = 2;
constexpr int IN_COLS = 3352, NIN = 3584  , NGU = 2 * DFF;
constexpr float EPS = 1e-6f;
enum { T_AU = 0, T_AV, T_BB, T_BC, T_BH, T_CQ, T_CK, T_CV, T_CZ, T_DQ, T_DK, T_DV, T_DZ, NPT };
constexpr size_t MiB = 1u << 20;
constexpr size_t WS_CTL = 0, CTL_ZERO_BYTES = 1 * MiB;
constexpr size_t WS_SSQ1 = 1 * MiB, WS_SSQ2 = WS_SSQ1 + 256 * 1024;
constexpr size_t WS_PS = 2 * MiB;
constexpr size_t WS_W0 = 4 * MiB;
constexpr size_t WOFF_IN = 0, WOFF_OUT = 7 * MiB, WOFF_GU = 9 * MiB, WOFF_DN = 20 * MiB;
constexpr size_t WS_XB = 30 * MiB;
constexpr size_t WS_MIX = 62 * MiB;
constexpr size_t WS_P = 94 * MiB;
constexpr size_t WS_OL = 198 * MiB;
constexpr size_t WS_QT = 230 * MiB;
constexpr size_t WS_AN = 246 * MiB;
constexpr size_t WS_DEC = 254 * MiB;
constexpr size_t WS_BN = WS_XB;
constexpr size_t WS_SN = WS_P;
constexpr size_t WS_TMP = 198 * MiB;
constexpr size_t WS_END = 256 * MiB;
static_assert(WS_P + (size_t)NPT * M * 256 * 2 <= WS_OL && (size_t)M * DFF * 2 <= WS_OL - WS_P, "ws map");
constexpr int CW_TMO = 0, CW_CODE = 1, CW_BAR = 4096;
constexpr int RING_OFF = 0, RING_BYTES = 131072;
constexpr int HALF_LDS = 73728;
constexpr int LDSCTL_OFF = 2 * HALF_LDS, MISC_OFF = LDSCTL_OFF + 320;
constexpr int LDS_BYTES = 163840;

#define GAS __attribute__((address_space(1)))
#define LAS __attribute__((address_space(3)))
typedef unsigned short bf16;
typedef unsigned v4u __attribute__((ext_vector_type(4)));
typedef unsigned v2u __attribute__((ext_vector_type(2)));
typedef float f32x4 __attribute__((ext_vector_type(4)));
typedef float f32x2 __attribute__((ext_vector_type(2)));
typedef short bf16x8 __attribute__((ext_vector_type(8)));
typedef GAS unsigned gu32;
#define RLX_AGENT __ATOMIC_RELAXED, __HIP_MEMORY_SCOPE_AGENT
#define LDS_WAIT() asm volatile("s_waitcnt lgkmcnt(0)" ::: "memory")
#define VM_WAIT() asm volatile("s_waitcnt vmcnt(0)" ::: "memory")
__device__ __forceinline__ unsigned f2bf(float f) { unsigned u = __builtin_bit_cast(unsigned, f); return (u + 0x7fffu + ((u >> 16) & 1u)) >> 16; }
__device__ __forceinline__ unsigned pk2(float lo, float hi) { return f2bf(lo) | (f2bf(hi) << 16); }
__device__ __forceinline__ float bf2f(unsigned short b) { return __builtin_bit_cast(float, (unsigned)b << 16); }
__device__ __forceinline__ float bflo(unsigned w) { return __builtin_bit_cast(float, w << 16); }
__device__ __forceinline__ float bfhi(unsigned w) { return __builtin_bit_cast(float, w & 0xffff0000u); }
__device__ __forceinline__ float siluf(float x) { return x / (1.0f + __expf(-x)); }
__device__ __forceinline__ float sigmoidf(float x) { return 1.0f / (1.0f + __expf(-x)); }
__device__ __forceinline__ float softplusf(float x) { return fmaxf(x, 0.f) + log1pf(__expf(-fabsf(x))); }
__device__ __forceinline__ float geluf(float x) { const float u = 0.7978845608028654f * (x + 0.044715f * x * x * x); return 0.5f * x * (1.0f + tanhf(u)); }
__device__ __forceinline__ float wave_sum(float v) {
#pragma unroll
    for (int o = 1; o < 64; o <<= 1) v += __shfl_xor(v, o);
    return v;
}
#define XB_TMO      128
#define XB_XCNT(j)  (256  + 64 * (j))
#define XB_XSUB(j)  (1280 + 64 * (j))
#define XB_XGEN(j)  (2304 + 64 * (j))
#define XB_TOP      3328
#define XB_TOPGEN   3392
#define XCD_BAR_WORDS 3456
#define XB_SPIN_CAP (1u << 18)

__device__ __forceinline__ unsigned xb_ld(unsigned* p)              { return __hip_atomic_load(p, __ATOMIC_RELAXED, __HIP_MEMORY_SCOPE_AGENT); }
__device__ __forceinline__ unsigned xb_add(unsigned* p, unsigned v) { return __hip_atomic_fetch_add(p, v, __ATOMIC_RELAXED, __HIP_MEMORY_SCOPE_AGENT); }
__device__ __forceinline__ unsigned xb_xcc_id() { return (unsigned)__builtin_amdgcn_s_getreg((3 << 11) | 20) & 0xFu; }
#define XB_SPIN(cond, bar) do { unsigned _sp = 0; while (cond) { __builtin_amdgcn_s_sleep(1); \
    if ((++_sp & 255u) == 0u) { if (xb_ld(&(bar)[XB_TMO])) break; if (_sp > XB_SPIN_CAP) { atomicAdd(&(bar)[XB_TMO], 1u); break; } } } } while (0)

struct XcdBarrier {
    unsigned* bar; unsigned x;
    volatile LAS unsigned* st;
};

__device__ __forceinline__ XcdBarrier xcd_barrier_post(unsigned* bar, volatile LAS unsigned* st) {
    XcdBarrier b; b.bar = bar; b.x = xb_xcc_id(); b.st = st;
    if (threadIdx.x == 0) (void)xb_add(&bar[XB_XCNT(b.x)], 1u);
    return b;
}
__device__ __forceinline__ void xcd_barrier_complete(unsigned* bar, unsigned x, unsigned& nloc, unsigned& nx) {
    const unsigned G = gridDim.x * gridDim.y * gridDim.z;
    unsigned sum, cnt, mine, sp = 0u;
    for (;;) {
        sum = 0u; cnt = 0u; mine = 0u;
#pragma unroll
        for (unsigned j = 0; j < 16; ++j) { const unsigned c = xb_ld(&bar[XB_XCNT(j)]); sum += c; cnt += (c > 0u) ? 1u : 0u; mine = (j == x) ? c : mine; }
        if (sum == G) break;
        __builtin_amdgcn_s_sleep(1);
        if ((++sp & 255u) == 0u) { if (xb_ld(&bar[XB_TMO])) break; if (sp > XB_SPIN_CAP) { atomicAdd(&bar[XB_TMO], 1u); break; } }
    }
    nloc = mine > 0u ? mine : 1u; nx = cnt > 0u ? cnt : 1u;
}

__device__ __forceinline__ void xcd_barrier(const XcdBarrier& b) {
    asm volatile("s_waitcnt vmcnt(0)" ::: "memory");
    __syncthreads();
    if (threadIdx.x == 0) {
        unsigned* bar = b.bar;
        __builtin_amdgcn_s_waitcnt(0);
        unsigned nloc = b.st[0], nx = b.st[1];
        if (nloc == 0u) { xcd_barrier_complete(bar, b.x, nloc, nx); b.st[0] = nloc; b.st[1] = nx; }
        const unsigned old = xb_add(&bar[XB_XSUB(b.x)], 1u);
        const unsigned gen = old / nloc;
        if (old + 1u == (gen + 1u) * nloc) {
            __builtin_amdgcn_fence(__ATOMIC_RELEASE, "agent");
            asm volatile("s_waitcnt vmcnt(0)" ::: "memory");
            const unsigned og = xb_add(&bar[XB_TOP], 1u);
            const unsigned tg = og / nx;
            if (og + 1u == (tg + 1u) * nx) xb_add(&bar[XB_TOPGEN], 1u);
            else XB_SPIN(xb_ld(&bar[XB_TOPGEN]) == tg, bar);
            __builtin_amdgcn_fence(__ATOMIC_ACQUIRE, "agent");
            xb_add(&bar[XB_XGEN(b.x)], 1u);
            asm volatile("s_waitcnt vmcnt(0)" ::: "memory");
        } else {
            XB_SPIN(xb_ld(&bar[XB_XGEN(b.x)]) == gen, bar);
            __builtin_amdgcn_fence(__ATOMIC_ACQUIRE, "agent");
            asm volatile("s_waitcnt vmcnt(0)" ::: "memory");
        }
    }
    __syncthreads();
}

struct Args { const float* in[20]; float* out; unsigned char* ws; int ph_lo, ph_hi, li, pad; };
enum { I_X = 0, I_N1W, I_WIN, I_SLNW, I_SLNB, I_SWS, I_SBS, I_SCW, I_DCW, I_DALOG, I_DDT, I_DNW, I_GW2, I_GB, I_GNW, I_WOUT, I_N2W, I_WGU, I_WDN, I_FNW };
struct Frame {
    LAS unsigned char* lds;
    volatile LAS unsigned* MISC;
    gu32* ctl;
    int tid, lane, wave;
    int vcu, NG;
};

__device__ __forceinline__ int map_win(int d) {
    const int t = d >> 8, j = d & 255;
    if (t < 8) return d;
    if (t == 8) return 2056 + j; if (t == 9) return 2312 + j; if (t == 10) return 2568 + j; if (t == 11) return 2824 + j; if (t == 12) return 3096 + j;
    if (j < 4) return 2048 + j; if (j < 8) return 2052 + (j - 4); if (j < 24) return 3080 + (j - 8); return -1;
}
__device__ __forceinline__ int map_wgu(int d) { const int t = d >> 8, j = d & 255; return j < 128 ? 128 * t + j : DFF + 128 * t + (j - 128); }
template <int MAP> __device__ __forceinline__ void transpose_item(const float* W, int K, int N, int ND, bf16* WT, const float* kscale, LAS float* scr, int item, int lane) {
    const int nblk = ND / 32, kb = item / nblk, nb = item % nblk, k0 = 64 * kb, d0 = 32 * nb;
    const int dd = d0 + (lane & 31); const int sc = MAP == 1 ? map_win(dd) : (MAP == 2 ? map_wgu(dd) : dd);
#pragma unroll 8
    for (int i = 0; i < 32; ++i) { const int kk = 2 * i + (lane >> 5); float v = sc >= 0 ? W[(size_t)(k0 + kk) * N + sc] : 0.f; if (kscale) v *= kscale[k0 + kk]; scr[kk * 33 + (lane & 31)] = v; }
    LDS_WAIT(); asm volatile("" ::: "memory");
    const int c = lane & 7;
#pragma unroll
    for (int j = 0; j < 4; ++j) { const int n = (lane >> 3) + 8 * j; const LAS float* s = scr + (8 * c) * 33 + n;
        v4u o; o.x = pk2(s[0 * 33], s[1 * 33]); o.y = pk2(s[2 * 33], s[3 * 33]); o.z = pk2(s[4 * 33], s[5 * 33]); o.w = pk2(s[6 * 33], s[7 * 33]);
        *(GAS v4u*)(WT + (size_t)(d0 + n) * K + k0 + 8 * c) = o; }
    LDS_WAIT(); asm volatile("" ::: "memory");
}
constexpr int IT_IN = (D / 64) * (NIN / 32), IT_OUT = (D / 64) * (D / 32), IT_GU = (D / 64) * (NGU / 32), IT_DN = (DFF / 64) * (D / 32), IT_LAYER = IT_IN + IT_OUT + IT_GU + IT_DN;
typedef const __attribute__((address_space(4))) Args* KArgsP;
__device__ __forceinline__ KArgsP kargs2() { KArgsP p = (KArgsP)__builtin_amdgcn_kernarg_segment_ptr(); asm volatile("" : "+s"(p)); return p; }
__device__ __forceinline__ void convert_weights(int layer, int sel_mask, LAS float* scr, int gw, int ngw, int lane) {
#pragma unroll 1
    for (int it = gw; it < IT_LAYER; it += ngw) {
        KArgsP a = kargs2();
        unsigned char* wb = a->ws + WS_W0;
        int r = it;
        if (r < IT_IN) { if (sel_mask & 1) transpose_item<1>(a->in[I_WIN] + (size_t)layer * D * IN_COLS, D, IN_COLS, NIN, (bf16*)(wb + WOFF_IN), a->in[I_N1W] + layer * D, scr, r, lane); continue; } r -= IT_IN;
        if (r < IT_OUT) { if (sel_mask & 2) transpose_item<0>(a->in[I_WOUT] + (size_t)layer * D * D, D, D, D, (bf16*)(wb + WOFF_OUT), nullptr, scr, r, lane); continue; } r -= IT_OUT;
        if (r < IT_GU) { if (sel_mask & 4) transpose_item<2>(a->in[I_WGU] + (size_t)layer * D * NGU, D, NGU, NGU, (bf16*)(wb + WOFF_GU), a->in[I_N2W] + layer * D, scr, r, lane); continue; } r -= IT_GU;
        if (sel_mask & 8) transpose_item<0>(a->in[I_WDN] + (size_t)layer * DFF * D, DFF, D, D, (bf16*)(wb + WOFF_DN), nullptr, scr, r, lane);
    }
}
__device__ __forceinline__ void x_row_prep(const float* xrow, bf16* orow, float* ssq4, int lane) {
    const GAS f32x4* xr = (const GAS f32x4*)xrow + lane; f32x4 v[4]; float s = 0.f;
#pragma unroll
    for (int j = 0; j < 4; ++j) { v[j] = xr[64 * j]; s += (v[j].x * v[j].x + v[j].y * v[j].y) + (v[j].z * v[j].z + v[j].w * v[j].w); }
    s = wave_sum(s);
    GAS unsigned long long* o8 = (GAS unsigned long long*)orow + lane;
#pragma unroll
    for (int j = 0; j < 4; ++j) o8[64 * j] = (unsigned long long)pk2(v[j].x, v[j].y) | ((unsigned long long)pk2(v[j].z, v[j].w) << 32);
    if (lane == 0) *(f32x4*)ssq4 = (f32x4){s, 0.f, 0.f, 0.f};
}
__device__ __forceinline__ void final_row(float* row, const float* ssq4, const float* fw, int lane) {
    const f32x4 s = *(const f32x4*)ssq4; const float rs = rsqrtf(((s[0] + s[1]) + (s[2] + s[3])) * (1.0f / D) + EPS);
    GAS f32x4* xr = (GAS f32x4*)row + lane; const GAS f32x4* wr = (const GAS f32x4*)fw + lane;
#pragma unroll
    for (int j = 0; j < 4; ++j) { const f32x4 v = xr[64 * j], w = wr[64 * j]; xr[64 * j] = v * rs * w; }
}

typedef const __attribute__((address_space(4))) Args* KArgs;
__device__ __forceinline__ KArgs kargs() { KArgs p = (KArgs)__builtin_amdgcn_kernarg_segment_ptr(); asm volatile("" : "+s"(p)); return p; }
typedef short s16x4 __attribute__((ext_vector_type(4)));
__device__ __forceinline__ s16x4 tr16(const LAS unsigned char* p) { return __builtin_bit_cast(s16x4, __builtin_amdgcn_ds_read_tr16_b64_v4i16((LAS s16x4*)p)); }
__device__ __forceinline__ bf16x8 cat8(s16x4 lo, s16x4 hi) { return __builtin_shufflevector(lo, hi, 0, 1, 2, 3, 4, 5, 6, 7); }
__device__ __forceinline__ unsigned cvtpk(float lo, float hi) { return pg8::cvt_pk_bf16(lo, hi); }
#define MFMA16(a, b, c) __builtin_amdgcn_mfma_f32_16x16x32_bf16((a), (b), (c), 0, 0, 0)
constexpr int SGU_RS = 544;
__device__ __forceinline__ void sgu_item(KArgs a, unsigned char* ws, int l, int ck, LAS unsigned char* sm, int wv, int lane) {
    const bf16* Pav = (const bf16*)(ws + WS_P) + (size_t)T_AV * M * 256; const bf16* Pau = (const bf16*)(ws + WS_P) + (size_t)T_AU * M * 256; bf16* MIX = (bf16*)(ws + WS_MIX);
    const int t0 = ck * 128;
    {
        const f32x4 lw = *(const f32x4*)(a->in[I_SLNW] + l * 256 + 4 * lane), lb = *(const f32x4*)(a->in[I_SLNB] + l * 256 + 4 * lane);
#pragma unroll 4
        for (int rr = 0; rr < 16; ++rr) {
            const int sr = wv * 16 + rr; const v2u w = *(const v2u*)(Pav + (size_t)(t0 + sr) * 256 + 4 * lane);
            float v[4] = {geluf(bflo(w.x)), geluf(bfhi(w.x)), geluf(bflo(w.y)), geluf(bfhi(w.y))};
            const float mu = wave_sum((v[0] + v[1]) + (v[2] + v[3])) * (1.0f / 256.0f); float q = 0.f;
#pragma unroll
            for (int i = 0; i < 4; ++i) { v[i] -= mu; q += v[i] * v[i]; }
            const float rstd = rsqrtf(wave_sum(q) * (1.0f / 256.0f) + EPS);
            v2u o; o.x = cvtpk(v[0] * rstd * lw[0] + lb[0], v[1] * rstd * lw[1] + lb[1]); o.y = cvtpk(v[2] * rstd * lw[2] + lb[2], v[3] * rstd * lw[3] + lb[3]);
            *(LAS v2u*)(sm + sr * SGU_RS + 8 * lane) = o;
        }
    }
    __syncthreads();
    {
        const int h = wv >> 1, cb0 = 2 * (wv & 1), li = lane & 15, g = lane >> 4;
        const float* Wh = a->in[I_SWS] + ((size_t)l * 4 + h) * 128 * 128; const float* bsh = a->in[I_SBS] + (l * 4 + h) * 128;
        const LAS unsigned char* vbase = sm + (8 * g + (li >> 2)) * SGU_RS + (64 * h + 16 * cb0 + 4 * (li & 3)) * 2;
#pragma unroll 1
        for (int tb = 0; tb < 8; ++tb) {
            const int tt = 16 * tb + li; f32x4 acc[2] = {(f32x4){0.f, 0.f, 0.f, 0.f}, (f32x4){0.f, 0.f, 0.f, 0.f}};
            const int nks = (tb >> 1) + 1;
#pragma unroll 1
            for (int ks = 0; ks < nks; ++ks) {
                const float* wp = Wh + (size_t)tt * 128 + 32 * ks + 8 * g; const f32x4 w0 = *(const f32x4*)wp, w1 = *(const f32x4*)(wp + 4);
                const int s0 = 32 * ks + 8 * g; float wf[8] = {w0[0], w0[1], w0[2], w0[3], w1[0], w1[1], w1[2], w1[3]};
#pragma unroll
                for (int j = 0; j < 8; ++j) if (s0 + j > tt) wf[j] = 0.f;
                v4u wb; wb.x = cvtpk(wf[0], wf[1]); wb.y = cvtpk(wf[2], wf[3]); wb.z = cvtpk(wf[4], wf[5]); wb.w = cvtpk(wf[6], wf[7]);
                const bf16x8 bfrag = __builtin_bit_cast(bf16x8, wb);
#pragma unroll
                for (int cbl = 0; cbl < 2; ++cbl) {
                    const LAS unsigned char* vp = vbase + 32 * ks * SGU_RS + cbl * 32;
                    const bf16x8 afrag = cat8(tr16(vp), tr16(vp + 4 * SGU_RS));
                    acc[cbl] = MFMA16(afrag, bfrag, acc[cbl]);
                }
            }
            const float bt = bsh[tt]; const size_t row = (size_t)(t0 + tt);
#pragma unroll
            for (int cbl = 0; cbl < 2; ++cbl) {
                const int c = 64 * h + 16 * (cb0 + cbl) + 4 * g; const v2u uw = *(const v2u*)(Pau + row * 256 + c);
                v2u o; o.x = cvtpk(geluf(bflo(uw.x)) * (acc[cbl][0] + bt), geluf(bfhi(uw.x)) * (acc[cbl][1] + bt)); o.y = cvtpk(geluf(bflo(uw.y)) * (acc[cbl][2] + bt), geluf(bfhi(uw.y)) * (acc[cbl][3] + bt));
                *(v2u*)(MIX + row * D + c) = o;
            }
        }
    }
    __syncthreads();
}
__device__ __forceinline__ void shortconv_task(const bf16* Pbb, const bf16* Pbc, const bf16* Pbh, const float* cw, bf16* MIX, int t, int cg) {
    const int tb = t & (SEQ - 1), c = 8 * cg; float y[8];
#pragma unroll
    for (int i = 0; i < 8; ++i) y[i] = 0.f;
#pragma unroll
    for (int k = 0; k < 3; ++k) { const int o = k - 2;
        if (tb + o >= 0) { const v4u xc = *(const v4u*)(Pbc + (size_t)(t + o) * 256 + c), xh = *(const v4u*)(Pbh + (size_t)(t + o) * 256 + c);
            const f32x4 w0 = *(const f32x4*)(cw + k * 256 + c), w1 = *(const f32x4*)(cw + k * 256 + c + 4);
            y[0] += w0[0] * bflo(xc.x) * bflo(xh.x); y[1] += w0[1] * bfhi(xc.x) * bfhi(xh.x); y[2] += w0[2] * bflo(xc.y) * bflo(xh.y); y[3] += w0[3] * bfhi(xc.y) * bfhi(xh.y);
            y[4] += w1[0] * bflo(xc.z) * bflo(xh.z); y[5] += w1[1] * bfhi(xc.z) * bfhi(xh.z); y[6] += w1[2] * bflo(xc.w) * bflo(xh.w); y[7] += w1[3] * bfhi(xc.w) * bfhi(xh.w); } }
    const v4u xb = *(const v4u*)(Pbb + (size_t)t * 256 + c); v4u o;
    o.x = cvtpk(bflo(xb.x) * y[0], bfhi(xb.x) * y[1]); o.y = cvtpk(bflo(xb.y) * y[2], bfhi(xb.y) * y[3]); o.z = cvtpk(bflo(xb.z) * y[4], bfhi(xb.z) * y[5]); o.w = cvtpk(bflo(xb.w) * y[6], bfhi(xb.w) * y[7]);
    *(v4u*)(MIX + (size_t)t * D + 256 + c) = o;
}

__device__ __forceinline__ v4u pack8(const f32x4& a, const f32x4& b) { v4u w; w.x = cvtpk(a[0], a[1]); w.y = cvtpk(a[2], a[3]); w.z = cvtpk(b[0], b[1]); w.w = cvtpk(b[2], b[3]); return w; }
__device__ __forceinline__ void scan_task(unsigned char* ws, int s, int slice, int lane) {
    const int g = lane >> 4; const bool gla = s >= 8;
    f32x4 S[4];
#pragma unroll
    for (int i = 0; i < 4; ++i) S[i] = (f32x4){0.f, 0.f, 0.f, 0.f};
    const unsigned char* bn = ws + WS_BN + (size_t)s * 128 * 16384 + (size_t)(slice * 4 * 64 + lane) * 16;
    unsigned char* sn = ws + WS_SN + (size_t)s * 128 * 8192 + (size_t)(slice * 2 * 64 + lane) * 16;
    const unsigned char* an = ws + WS_AN + (size_t)s * 128 * 8192 + (size_t)lane * 16;
    const float* dec = (const float*)(ws + WS_DEC) + (size_t)(s - 8) * 128 * 64 + 4 * g;
#pragma unroll 2
    for (int n = 0; n < 128; ++n) {
        const v4u f0 = pack8(S[0], S[1]), f1 = pack8(S[2], S[3]);
        *(v4u*)(sn + (size_t)n * 8192) = f0; *(v4u*)(sn + (size_t)n * 8192 + 1024) = f1;
        f32x4 Bv[4];
#pragma unroll
        for (int i = 0; i < 4; ++i) Bv[i] = *(const f32x4*)(bn + (size_t)n * 16384 + i * 1024);
        if (gla) {
#pragma unroll
            for (int i = 0; i < 4; ++i) { const f32x4 d4 = *(const f32x4*)(dec + (size_t)n * 64 + 16 * i); S[i] = d4 * S[i] + Bv[i]; }
        } else {
            const bf16x8 b0 = __builtin_bit_cast(bf16x8, f0), b1 = __builtin_bit_cast(bf16x8, f1);
#pragma unroll
            for (int i = 0; i < 4; ++i) {
                const bf16x8 a0 = *(const bf16x8*)(an + (size_t)n * 8192 + (i * 2 + 0) * 1024), a1 = *(const bf16x8*)(an + (size_t)n * 8192 + (i * 2 + 1) * 1024);
                f32x4 acc = MFMA16(a0, b0, Bv[i]); S[i] = MFMA16(a1, b1, acc);
            }
        }
    }
}
__device__ __forceinline__ void pass3_task(KArgs a, unsigned char* ws, int l, int cid, int i, int lane) {
    const int li = lane & 15, g = lane >> 4, s = cid >> 7, n = cid & 127, kind = s >> 3, b = (s >> 2) & 1, h = s & 3;
    const unsigned char* qt = ws + WS_QT + (size_t)cid * 8192 + (size_t)(i * 2 * 64 + lane) * 16;
    const bf16x8 q0 = *(const bf16x8*)qt, q1 = *(const bf16x8*)(qt + 1024);
    const unsigned char* sn = ws + WS_SN + (size_t)cid * 8192 + (size_t)lane * 16; const unsigned char* ol = ws + WS_OL + (size_t)cid * 16384 + (size_t)(i * 64 + lane) * 16;
    f32x4 o[4]; float ss = 0.f;
#pragma unroll
    for (int cb = 0; cb < 4; ++cb) {
        f32x4 acc = *(const f32x4*)(ol + cb * 4096);
        acc = MFMA16(*(const bf16x8*)(sn + (cb * 2 + 0) * 1024), q0, acc); acc = MFMA16(*(const bf16x8*)(sn + (cb * 2 + 1) * 1024), q1, acc);
        o[cb] = acc; ss += (acc[0] * acc[0] + acc[1] * acc[1]) + (acc[2] * acc[2] + acc[3] * acc[3]);
    }
    ss += __shfl_xor(ss, 16); ss += __shfl_xor(ss, 32);
    const float rstd = rsqrtf(ss * (1.0f / 64.0f) + EPS);
    const size_t row = (size_t)b * SEQ + n * 64 + 16 * i + li;
    const bf16* Pz = (const bf16*)(ws + WS_P) + (size_t)(kind ? T_DZ : T_CZ) * M * 256 + row * 256 + h * 64 + 4 * g;
    bf16* mo = (bf16*)(ws + WS_MIX) + row * D + (kind ? 768 : 512) + h * 64 + 4 * g;
    const float* nw = (kind ? a->in[I_GNW] : a->in[I_DNW]) + l * 64 + 4 * g;
#pragma unroll
    for (int cb = 0; cb < 4; ++cb) {
        const f32x4 w4 = *(const f32x4*)(nw + 16 * cb); const v2u z = *(const v2u*)(Pz + 16 * cb);
        v2u y; y.x = cvtpk(o[cb][0] * rstd * w4[0] * siluf(bflo(z.x)), o[cb][1] * rstd * w4[1] * siluf(bfhi(z.x))); y.y = cvtpk(o[cb][2] * rstd * w4[2] * siluf(bflo(z.y)), o[cb][3] * rstd * w4[3] * siluf(bfhi(z.y)));
        *(v2u*)(mo + 16 * cb) = y;
    }
}
constexpr int CRS = 144;
constexpr int G_QA = 0, G_KA = 9216, G_KL = 18432, G_QG = 27648, G_VR = 36864, G_ATT = 46080, G_GL = 55296, G_PART = 59392, G_MID = 60416, G_LAST = 60672;
__device__ __forceinline__ void gla_pass1(KArgs a, unsigned char* ws, int l, int item, LAS unsigned char* hb, int ht, int hw, int lane) {
    const int n = item & 127, bh = item >> 7, b = bh >> 2, h = bh & 3, t0 = b * SEQ + n * 64, cid = 1024 + item, li = lane & 15, g = lane >> 4;
    const bf16* Pq = (const bf16*)(ws + WS_P) + (size_t)T_DQ * M * 256 + h * 64; const bf16* Pk = (const bf16*)(ws + WS_P) + (size_t)T_DK * M * 256 + h * 64; const bf16* Pv = (const bf16*)(ws + WS_P) + (size_t)T_DV * M * 256 + h * 64;
    const float* PS = (const float*)(ws + WS_PS);
    {
        const int c = ht >> 2, part = ht & 3;
        *(LAS f32x4*)(hb + G_GL + c * 64 + part * 16) = *(const f32x4*)(PS + (size_t)(t0 + c) * 32 + 8 + 4 * part);
        const v4u v0 = *(const v4u*)(Pv + (size_t)(t0 + c) * 256 + part * 16), v1 = *(const v4u*)(Pv + (size_t)(t0 + c) * 256 + part * 16 + 8);
        *(LAS v4u*)(hb + G_VR + c * CRS + part * 32) = v0; *(LAS v4u*)(hb + G_VR + c * CRS + part * 32 + 16) = v1;
    }
    __syncthreads();
    {
        const int d = ht & 63, cq = ht >> 6; float cum[16];
        {
            float w2[16];
#pragma unroll
            for (int r = 0; r < 16; ++r) w2[r] = a->in[I_GW2][(size_t)(l * 16 + r) * 256 + h * 64 + d];
            const float bias = a->in[I_GB][l * 256 + h * 64 + d]; float run = 0.f;
#pragma unroll
            for (int cc = 0; cc < 16; ++cc) {
                const LAS f32x4* gl = (const LAS f32x4*)(hb + G_GL + (16 * cq + cc) * 64); float pre = bias;
#pragma unroll
                for (int r4 = 0; r4 < 4; ++r4) { const f32x4 gv = gl[r4]; pre += gv[0] * w2[4 * r4] + gv[1] * w2[4 * r4 + 1] + gv[2] * w2[4 * r4 + 2] + gv[3] * w2[4 * r4 + 3]; }
                run += -softplusf(-pre) * (1.0f / 16.0f); cum[cc] = run;
            }
            ((LAS float*)(hb + G_PART))[cq * 64 + d] = run;
        }
        __syncthreads();
        float off = 0.f;
#pragma unroll
        for (int q2 = 0; q2 < 3; ++q2) if (q2 < cq) off += ((LAS float*)(hb + G_PART))[q2 * 64 + d];
#pragma unroll
        for (int cc = 0; cc < 16; ++cc) cum[cc] += off;
        if (cq == 2) ((LAS float*)(hb + G_MID))[d] = cum[0];
        if (cq == 3) { ((LAS float*)(hb + G_LAST))[d] = cum[15]; ((float*)(ws + WS_DEC))[(size_t)item * 64 + d] = __expf(cum[15]); }
        __syncthreads();
        const float gmid = ((LAS float*)(hb + G_MID))[d], glast = ((LAS float*)(hb + G_LAST))[d];
#pragma unroll
        for (int cc = 0; cc < 16; ++cc) {
            const int c = 16 * cq + cc; const float gc = cum[cc];
            const float qv = bf2f(Pq[(size_t)(t0 + c) * 256 + d]) * 0.125f, kv = bf2f(Pk[(size_t)(t0 + c) * 256 + d]);
            *(LAS bf16*)(hb + G_QA + c * CRS + 2 * d) = (bf16)f2bf(qv * __expf(gc - gmid));
            *(LAS bf16*)(hb + G_KA + c * CRS + 2 * d) = (bf16)f2bf(kv * __expf(gmid - gc));
            *(LAS bf16*)(hb + G_QG + c * CRS + 2 * d) = (bf16)f2bf(qv * __expf(gc));
            *(LAS bf16*)(hb + G_KL + c * CRS + 2 * d) = (bf16)f2bf(kv * __expf(glast - gc));
        }
    }
    __syncthreads();
    {
        int blk = 0;
#pragma unroll
        for (int bt = 0; bt < 4; ++bt)
#pragma unroll
            for (int bj = 0; bj < 4; ++bj, ++blk) {
                if ((blk & 3) != hw) continue;
                const int t = 16 * bt + li; v2u o;
                if (bj <= bt) {
                    f32x4 acc = (f32x4){0.f, 0.f, 0.f, 0.f};
#pragma unroll
                    for (int ks = 0; ks < 2; ++ks) acc = MFMA16(*(const LAS bf16x8*)(hb + G_KA + (16 * bj + li) * CRS + (32 * ks + 8 * g) * 2), *(const LAS bf16x8*)(hb + G_QA + t * CRS + (32 * ks + 8 * g) * 2), acc);
                    const int j0 = 16 * bj + 4 * g;
#pragma unroll
                    for (int r = 0; r < 4; ++r) if (j0 + r > t) acc[r] = 0.f;
                    o.x = cvtpk(acc[0], acc[1]); o.y = cvtpk(acc[2], acc[3]);
                } else { o.x = 0u; o.y = 0u; }
                *(LAS v2u*)(hb + G_ATT + t * CRS + (16 * bj + 4 * g) * 2) = o;
            }
#pragma unroll
        for (int q2 = 0; q2 < 2; ++q2) {
            const int idx = hw * 2 + q2, i = idx >> 1, ks = idx & 1; const LAS unsigned char* qp = hb + G_QG + (16 * i + li) * CRS + (32 * ks + 4 * g) * 2;
            const v2u lo = *(const LAS v2u*)qp, hi = *(const LAS v2u*)(qp + 32); v4u w; w.x = lo.x; w.y = lo.y; w.z = hi.x; w.w = hi.y;
            *(v4u*)(ws + WS_QT + (size_t)cid * 8192 + (size_t)((i * 2 + ks) * 64 + lane) * 16) = w;
        }
    }
    __syncthreads();
    {
        const int eb = hw;
        const LAS unsigned char* vtr = hb + G_VR + (8 * g + (li >> 2)) * CRS + (16 * eb + 4 * (li & 3)) * 2;
        bf16x8 vf[2];
#pragma unroll
        for (int ks = 0; ks < 2; ++ks) vf[ks] = cat8(tr16(vtr + 32 * ks * CRS), tr16(vtr + (32 * ks + 4) * CRS));
#pragma unroll
        for (int i = 0; i < 4; ++i) {
            f32x4 acc = (f32x4){0.f, 0.f, 0.f, 0.f};
#pragma unroll
            for (int ks = 0; ks < 2; ++ks) if (ks <= (i >> 1)) acc = MFMA16(vf[ks], *(const LAS bf16x8*)(hb + G_ATT + (16 * i + li) * CRS + (32 * ks + 8 * g) * 2), acc);
            *(f32x4*)(ws + WS_OL + (size_t)cid * 16384 + (size_t)((eb * 4 + i) * 64 + lane) * 16) = acc;
            f32x4 bacc = (f32x4){0.f, 0.f, 0.f, 0.f};
            const LAS unsigned char* ktr = hb + G_KL + (8 * g + (li >> 2)) * CRS + (16 * i + 4 * (li & 3)) * 2;
#pragma unroll
            for (int ks = 0; ks < 2; ++ks) bacc = MFMA16(cat8(tr16(ktr + 32 * ks * CRS), tr16(ktr + (32 * ks + 4) * CRS)), vf[ks], bacc);
            *(f32x4*)(ws + WS_BN + (size_t)cid * 16384 + (size_t)((eb * 4 + i) * 64 + lane) * 16) = bacc;
        }
    }
    __syncthreads();
}

constexpr int NRS = 272;
constexpr int D_RAW = 0, D_NLOW = 0, D_ATT = 17408, D_Q = 26624, D_K = 35840, D_KD = 45056, D_V = 54272, D_TII = 63488, D_GC = 67584, D_CW = 68608;
static_assert(D_CW + 3072 <= HALF_LDS && 3 * 67 * 128 <= D_Q, "DeltaNet LDS map");
#define MFMA4(a, b, c) __builtin_amdgcn_mfma_f32_16x16x4f32((a), (b), (c), 0, 0, 0)
__device__ __forceinline__ void dn_pass1(KArgs a, unsigned char* ws, int l, int item, LAS unsigned char* hb, int ht, int hw, int lane) {
    const int n = item & 127, bh = item >> 7, b = bh >> 2, h = bh & 3, t0 = b * SEQ + n * 64, cid = item, li = lane & 15, g = lane >> 4;
    LAS float* GC = (LAS float*)(hb + D_GC);
    {
#pragma unroll
        for (int X = 0; X < 3; ++X) {
            const bf16* PX = (const bf16*)(ws + WS_P) + (size_t)(T_CQ + X) * M * 256 + h * 64;
#pragma unroll 1
            for (int pi = ht; pi < 67 * 8; pi += 256) { const int r = pi >> 3, p8 = pi & 7; v4u v = {0u, 0u, 0u, 0u};
                if (n * 64 + r - 3 >= 0) v = *(const v4u*)(PX + (size_t)(t0 + r - 3) * 256 + p8 * 8);
                *(LAS v4u*)(hb + D_RAW + X * 67 * 128 + r * 128 + p8 * 16) = v; }
        }
        { const float* dcw = a->in[I_DCW] + (size_t)l * 4 * 768;
#pragma unroll
          for (int q3 = 0; q3 < 3; ++q3) { const int idx = ht + 256 * q3, X = idx >> 8, j = (idx >> 6) & 3, d = idx & 63; ((LAS float*)(hb + D_CW))[idx] = dcw[j * 768 + X * 256 + h * 64 + d]; } }
        if (hw == 0) {
            const float* PS = (const float*)(ws + WS_PS) + (size_t)(t0 + lane) * 32;
            float gv = -__expf(a->in[I_DALOG][l * 4 + h]) * softplusf(PS[h] + a->in[I_DDT][l * 4 + h]);
#pragma unroll
            for (int o = 1; o < 64; o <<= 1) { const float up = __shfl_up(gv, o); if (lane >= o) gv += up; }
            const float glast = __shfl(gv, 63);
            GC[lane] = gv; GC[64 + lane] = sigmoidf(PS[4 + h]); GC[128 + lane] = __expf(gv); GC[192 + lane] = __expf(glast - gv);
        }
    }
    __syncthreads();
    {
        const int c = ht >> 2, d0 = 16 * (ht & 3);
#pragma unroll
        for (int X = 0; X < 3; ++X) {
            float acc[16];
#pragma unroll
            for (int i = 0; i < 16; ++i) acc[i] = 0.f;
#pragma unroll
            for (int j = 0; j < 4; ++j) {
                const LAS unsigned char* rp = hb + D_RAW + X * 67 * 128 + (c + j) * 128 + d0 * 2; const v4u x0 = *(const LAS v4u*)rp, x1 = *(const LAS v4u*)(rp + 16);
                const LAS f32x4* wp = (const LAS f32x4*)(hb + D_CW + ((X * 4 + j) * 64 + d0) * 4); const f32x4 w0 = wp[0], w1 = wp[1], w2 = wp[2], w3 = wp[3];
                acc[0] += w0[0] * bflo(x0.x); acc[1] += w0[1] * bfhi(x0.x); acc[2] += w0[2] * bflo(x0.y); acc[3] += w0[3] * bfhi(x0.y);
                acc[4] += w1[0] * bflo(x0.z); acc[5] += w1[1] * bfhi(x0.z); acc[6] += w1[2] * bflo(x0.w); acc[7] += w1[3] * bfhi(x0.w);
                acc[8] += w2[0] * bflo(x1.x); acc[9] += w2[1] * bfhi(x1.x); acc[10] += w2[2] * bflo(x1.y); acc[11] += w2[3] * bfhi(x1.y);
                acc[12] += w3[0] * bflo(x1.z); acc[13] += w3[1] * bfhi(x1.z); acc[14] += w3[2] * bflo(x1.w); acc[15] += w3[3] * bfhi(x1.w);
            }
            float ss = 0.f;
#pragma unroll
            for (int i = 0; i < 16; ++i) { acc[i] = siluf(acc[i]); ss += acc[i] * acc[i]; }
            float sc = 1.0f;
            if (X < 2) { ss += __shfl_xor(ss, 1); ss += __shfl_xor(ss, 2); sc = rsqrtf(ss + EPS) * (X == 0 ? 0.125f : 1.0f); }
#pragma unroll
            for (int i = 0; i < 16; ++i) acc[i] *= sc;
            v4u o0, o1; o0.x = cvtpk(acc[0], acc[1]); o0.y = cvtpk(acc[2], acc[3]); o0.z = cvtpk(acc[4], acc[5]); o0.w = cvtpk(acc[6], acc[7]);
            o1.x = cvtpk(acc[8], acc[9]); o1.y = cvtpk(acc[10], acc[11]); o1.z = cvtpk(acc[12], acc[13]); o1.w = cvtpk(acc[14], acc[15]);
            LAS unsigned char* dst = hb + (X == 0 ? D_Q : (X == 1 ? D_K : D_V)) + c * CRS + d0 * 2;
            *(LAS v4u*)dst = o0; *(LAS v4u*)(dst + 16) = o1;
            if (X == 1) { const float e = GC[192 + c];
                o0.x = cvtpk(acc[0] * e, acc[1] * e); o0.y = cvtpk(acc[2] * e, acc[3] * e); o0.z = cvtpk(acc[4] * e, acc[5] * e); o0.w = cvtpk(acc[6] * e, acc[7] * e);
                o1.x = cvtpk(acc[8] * e, acc[9] * e); o1.y = cvtpk(acc[10] * e, acc[11] * e); o1.z = cvtpk(acc[12] * e, acc[13] * e); o1.w = cvtpk(acc[14] * e, acc[15] * e);
                LAS unsigned char* d2 = hb + D_KD + c * CRS + d0 * 2; *(LAS v4u*)d2 = o0; *(LAS v4u*)(d2 + 16) = o1; }
        }
    }
    __syncthreads();
    {
        int blk = 0;
#pragma unroll
        for (int bi = 0; bi < 4; ++bi)
#pragma unroll
            for (int bj = 0; bj < 4; ++bj, ++blk) {
                if ((blk & 3) != hw) continue;
                const int i = 16 * bi + li;
                if (bj <= bi) {
                    f32x4 aK = (f32x4){0.f, 0.f, 0.f, 0.f}, aQ = aK;
#pragma unroll
                    for (int ks = 0; ks < 2; ++ks) { const bf16x8 kj = *(const LAS bf16x8*)(hb + D_K + (16 * bj + li) * CRS + (32 * ks + 8 * g) * 2);
                        aK = MFMA16(kj, *(const LAS bf16x8*)(hb + D_K + i * CRS + (32 * ks + 8 * g) * 2), aK);
                        aQ = MFMA16(kj, *(const LAS bf16x8*)(hb + D_Q + i * CRS + (32 * ks + 8 * g) * 2), aQ); }
                    const float gci = GC[i], nbi = -GC[64 + i]; const f32x4 gcj = *(const LAS f32x4*)(GC + 16 * bj + 4 * g); const int j0 = 16 * bj + 4 * g;
                    f32x4 nl, at;
#pragma unroll
                    for (int r = 0; r < 4; ++r) { const float dcy = (j0 + r <= i) ? __expf(gci - gcj[r]) : 0.f; at[r] = aQ[r] * dcy; nl[r] = (j0 + r < i) ? nbi * aK[r] * dcy : 0.f; }
                    *(LAS f32x4*)(hb + D_NLOW + i * NRS + j0 * 4) = nl;
                    v2u o; o.x = cvtpk(at[0], at[1]); o.y = cvtpk(at[2], at[3]); *(LAS v2u*)(hb + D_ATT + i * CRS + j0 * 2) = o;
                } else { v2u o; o.x = 0u; o.y = 0u; *(LAS v2u*)(hb + D_ATT + i * CRS + (16 * bj + 4 * g) * 2) = o; }
            }
    }
    __syncthreads();
    if (hw == 0) {
        float x[16];
#pragma unroll
        for (int i = 0; i < 16; ++i) {
            const LAS f32x4* rp = (const LAS f32x4*)(hb + D_NLOW + (16 * g + i) * NRS + 16 * g * 4); float sacc = (i == li) ? 1.0f : 0.f;
#pragma unroll
            for (int j4 = 0; j4 < 4; ++j4) if (4 * j4 < i) { const f32x4 nl = rp[j4];
#pragma unroll
                for (int r = 0; r < 4; ++r) if (4 * j4 + r < i) sacc += nl[r] * x[4 * j4 + r]; }
            x[i] = sacc; ((LAS float*)(hb + D_TII))[(g * 16 + i) * 16 + li] = sacc;
        }
    }
    __syncthreads();
    {
        const int kind = hw >> 1; bf16x8 fr[2][2];
#pragma unroll
        for (int bl = 0; bl < 2; ++bl) {
            const int col = 16 * (2 * (hw & 1) + bl) + li; f32x4 X[4];
#pragma unroll
            for (int I = 0; I < 4; ++I) {
                f32x4 acc; const f32x4 b4 = *(const LAS f32x4*)(GC + 64 + 16 * I + 4 * g), e4 = *(const LAS f32x4*)(GC + 128 + 16 * I + 4 * g);
#pragma unroll
                for (int r = 0; r < 4; ++r) { const int c = 16 * I + 4 * g + r; acc[r] = kind ? bf2f(*(const LAS bf16*)(hb + D_V + c * CRS + col * 2)) * b4[r] : bf2f(*(const LAS bf16*)(hb + D_K + c * CRS + col * 2)) * b4[r] * e4[r]; }
#pragma unroll
                for (int J = 0; J < 4; ++J) if (J < I) { const f32x4 A4 = *(const LAS f32x4*)(hb + D_NLOW + (16 * I + li) * NRS + (16 * J + 4 * g) * 4);
#pragma unroll
                    for (int r = 0; r < 4; ++r) acc = MFMA4(A4[r], X[J][r], acc); }
                const f32x4 T4 = *(const LAS f32x4*)(hb + D_TII + ((I * 16 + li) * 16 + 4 * g) * 4); f32x4 z = (f32x4){0.f, 0.f, 0.f, 0.f};
#pragma unroll
                for (int r = 0; r < 4; ++r) z = MFMA4(T4[r], acc[r], z);
                X[I] = z;
            }
            fr[bl][0] = __builtin_bit_cast(bf16x8, pack8(X[0], X[1])); fr[bl][1] = __builtin_bit_cast(bf16x8, pack8(X[2], X[3]));
        }
        const float dec = GC[128 + 63];
#pragma unroll
        for (int i = 0; i < 4; ++i) {
            bf16x8 kdf[2], atf[2];
#pragma unroll
            for (int ks = 0; ks < 2; ++ks) {
                const LAS unsigned char* kp = hb + D_KD + (32 * ks + 4 * g + (li >> 2)) * CRS + (16 * i + 4 * (li & 3)) * 2; kdf[ks] = cat8(tr16(kp), tr16(kp + 16 * CRS));
                const LAS unsigned char* ap = hb + D_ATT + (16 * i + li) * CRS + (32 * ks + 4 * g) * 2; const v2u lo = *(const LAS v2u*)ap, hi = *(const LAS v2u*)(ap + 32);
                v4u w; w.x = lo.x; w.y = lo.y; w.z = hi.x; w.w = hi.y; atf[ks] = __builtin_bit_cast(bf16x8, w);
            }
            if (kind == 0) {
                f32x4 va[2], vq[2];
#pragma unroll
                for (int bl = 0; bl < 2; ++bl) {
                    f32x4 acc = (f32x4){0.f, 0.f, 0.f, 0.f};
#pragma unroll
                    for (int ks = 0; ks < 2; ++ks) acc = MFMA16(fr[bl][ks], kdf[ks], acc);
                    const int dp0 = 16 * (2 * hw + bl) + 4 * g;
#pragma unroll
                    for (int r = 0; r < 4; ++r) va[bl][r] = ((dp0 + r == 16 * i + li) ? dec : 0.f) - acc[r];
                    f32x4 qacc = (f32x4){0.f, 0.f, 0.f, 0.f};
#pragma unroll
                    for (int ks = 0; ks < 2; ++ks) if (ks <= (i >> 1)) qacc = MFMA16(fr[bl][ks], atf[ks], qacc);
                    const v2u qw = *(const LAS v2u*)(hb + D_Q + (16 * i + li) * CRS + dp0 * 2); const float eg = GC[128 + 16 * i + li];
                    vq[bl][0] = bflo(qw.x) * eg - qacc[0]; vq[bl][1] = bfhi(qw.x) * eg - qacc[1]; vq[bl][2] = bflo(qw.y) * eg - qacc[2]; vq[bl][3] = bfhi(qw.y) * eg - qacc[3];
                }
                *(v4u*)(ws + WS_AN + (size_t)cid * 8192 + (size_t)((i * 2 + hw) * 64 + lane) * 16) = pack8(va[0], va[1]);
                *(v4u*)(ws + WS_QT + (size_t)cid * 8192 + (size_t)((i * 2 + hw) * 64 + lane) * 16) = pack8(vq[0], vq[1]);
            } else {
#pragma unroll
                for (int bl = 0; bl < 2; ++bl) {
                    const int eb = 2 * (hw & 1) + bl; f32x4 acc = (f32x4){0.f, 0.f, 0.f, 0.f};
#pragma unroll
                    for (int ks = 0; ks < 2; ++ks) acc = MFMA16(kdf[ks], fr[bl][ks], acc);
                    *(f32x4*)(ws + WS_BN + (size_t)cid * 16384 + (size_t)((eb * 4 + i) * 64 + lane) * 16) = acc;
                    f32x4 oacc = (f32x4){0.f, 0.f, 0.f, 0.f};
#pragma unroll
                    for (int ks = 0; ks < 2; ++ks) if (ks <= (i >> 1)) oacc = MFMA16(fr[bl][ks], atf[ks], oacc);
                    *(f32x4*)(ws + WS_OL + (size_t)cid * 16384 + (size_t)((eb * 4 + i) * 64 + lane) * 16) = oacc;
                }
            }
        }
    }
    __syncthreads();
}

constexpr int PH_PRO = 0, PH_PER_LAYER = 7, PH_FINAL = 1 + DEPTH * PH_PER_LAYER, N_PHASES = PH_FINAL + 1;
__global__ void __launch_bounds__(NWAVES * 64, 2) mk_fwd(Args args_unused) {
    extern __shared__ __attribute__((aligned(16))) unsigned char lds[];
    Frame F;
    F.lds = (LAS unsigned char*)lds;
    F.MISC = (volatile LAS unsigned*)(F.lds + MISC_OFF);
    F.tid = threadIdx.x; F.lane = F.tid & 63; F.wave = __builtin_amdgcn_readfirstlane(F.tid >> 6);
    F.NG = gridDim.x; { const int bx = blockIdx.x; F.vcu = (F.NG % 8 == 0) ? (bx % 8) * (F.NG / 8) + bx / 8 : bx; }
    for (int u = F.tid; u < (LDS_BYTES - LDSCTL_OFF) / 4; u += NWAVES * 64) ((LAS unsigned*)(F.lds + LDSCTL_OFF))[u] = 0u;
    __syncthreads();
    int lo, hi; { KArgs a = kargs(); lo = a->ph_lo; hi = a->ph_hi; F.ctl = (gu32*)(a->ws + WS_CTL); }
    XcdBarrier bar; bar.bar = (unsigned*)(F.ctl + CW_BAR); bar.x = 0; bar.st = nullptr;
    if (hi - lo > 1) bar = xcd_barrier_post((unsigned*)(F.ctl + CW_BAR), F.MISC + 8);
#pragma unroll 1
    for (int ph = lo; ph < hi; ++ph) {
        KArgs a = kargs();
        int NG = F.NG, bx = blockIdx.x, vcu = F.vcu, wv = F.wave; asm volatile("" : "+s"(NG), "+s"(bx), "+s"(vcu), "+s"(wv));
        int lane_l = F.lane; asm volatile("" : "+v"(lane_l));
        const int gw = vcu * NWAVES + wv, ngw = NG * NWAVES;
        unsigned char* const ws = a->ws;
        if (ph == PH_PRO) {
            LAS float* scr = (LAS float*)(F.lds + RING_OFF + wv * 16384);
            convert_weights(0, 15, scr, gw, ngw, lane_l);
            const float* x = a->in[I_X];
#pragma unroll 1
            for (int m = gw; m < M; m += ngw) x_row_prep(x + (size_t)m * D, (bf16*)(ws + WS_XB) + (size_t)m * D, (float*)(ws + WS_SSQ2) + (size_t)m * 4, lane_l);
        } else if (ph == PH_FINAL) {
            float* xres = a->out; const float* fw = a->in[I_FNW];
#pragma unroll 1
            for (int m = gw; m < M; m += ngw) final_row(xres + (size_t)m * D, (float*)(ws + WS_SSQ2) + (size_t)m * 4, fw, lane_l);
        } else {
            const int l = (ph - 1) / PH_PER_LAYER, sub = (ph - 1) % PH_PER_LAYER;
            unsigned char* wb = ws + WS_W0;
            if (sub == 0) {
                pg8::Gemm g{(const bf16*)(ws + WS_XB), (const bf16*)(wb + WOFF_IN), M, NIN, D}; pg8::StaticOrder S; S.init(M, NIN, NG, bx);
                pg8::EpiIn E{(bf16*)(ws + WS_P), (float*)(ws + WS_PS), (const float*)(ws + WS_SSQ2)};
                pg8::gemm_phase<pg8::EpiIn, pg8::StaticOrder, true, true>(F.lds + RING_OFF, g, S, E);
            } else if (sub == 4 || sub == 6) {
                const bool dn = (sub == 6);
                pg8::Gemm g{(const bf16*)(ws + (dn ? WS_P : WS_MIX)), (const bf16*)(wb + (dn ? WOFF_DN : WOFF_OUT)), M, D, dn ? DFF : D}; pg8::StaticOrder S; S.init(M, D, NG, bx);
                float* xres = a->out;
                pg8::EpiRes E{(!dn && l == 0) ? a->in[I_X] : xres, xres, (bf16*)(ws + WS_XB), (float*)(ws + (dn ? WS_SSQ2 : WS_SSQ1))};
                if (NG == 256) pg8::gemm_phase<pg8::EpiRes, pg8::StaticOrder, false, true>(F.lds + RING_OFF, g, S, E);
            } else if (sub == 5) {
                pg8::Gemm g{(const bf16*)(ws + WS_XB), (const bf16*)(wb + WOFF_GU), M, NGU, D}; pg8::StaticOrder S; S.init(M, NGU, NG, bx);
                pg8::EpiGU E{(bf16*)(ws + WS_P), (const float*)(ws + WS_SSQ1)};
                pg8::gemm_phase<pg8::EpiGU, pg8::StaticOrder, true, true>(F.lds + RING_OFF, g, S, E);
            } else if (sub == 1) {
                if (bx < 128) sgu_item(a, ws, l, bx, F.lds + RING_OFF, wv, lane_l);
                else {
                    const bf16* P = (const bf16*)(ws + WS_P); bf16* MIX = (bf16*)(ws + WS_MIX); const float* scw = a->in[I_SCW] + l * 3 * 256;
                    const int nth = (NG - 128) * NWAVES * 64;
#pragma unroll 1
                    for (int i = ((bx - 128) * NWAVES + wv) * 64 + lane_l; i < M * 32; i += nth) shortconv_task(P + (size_t)T_BB * M * 256, P + (size_t)T_BC * M * 256, P + (size_t)T_BH * M * 256, scw, MIX, i >> 5, i & 31);
                }
                __syncthreads();
                {
                    const int half = wv >> 2, hw = wv & 3, ht = hw * 64 + lane_l;
#pragma unroll 1
                    for (int it = bx * 2 + half; it < 1024; it += NG * 2) gla_pass1(a, ws, l, it, F.lds + RING_OFF + half * HALF_LDS, ht, hw, lane_l);
#pragma unroll 1
                    for (int it = bx * 2 + half; it < 1024; it += NG * 2) dn_pass1(a, ws, l, it, F.lds + RING_OFF + half * HALF_LDS, ht, hw, lane_l);
                }
            } else if (sub == 2) {
                if (bx < 16) {
                    if (wv < 4) scan_task(ws, bx, wv, lane_l);
                } else {
                    LAS float* scr = (LAS float*)(F.lds + RING_OFF + wv * 16384);
                    convert_weights(1, l == 0 ? 1 : 14, scr, (bx - 16) * NWAVES + wv, (NG - 16) * NWAVES, lane_l);
                }
            } else {
#pragma unroll 1
                for (int i = gw; i < 2048 * 4; i += ngw) pass3_task(a, ws, l, i >> 2, i & 3, lane_l);
            }
        }
        if (ph + 1 < hi) xcd_barrier(bar);
    }
}

extern "C" void kernel_launch(void* const* d_in, const int* in_sizes, int n_in, void* d_out, int out_size, void* d_ws, size_t ws_size, hipStream_t stream) {
    static int grid = 0;
    if (grid == 0) {
        if (n_in != 20 || in_sizes[0] != M * D || out_size != M * D || ws_size < WS_END) { fprintf(stderr, "kernel_launch: unexpected shapes (n_in %d in0 %d out %d ws %zu)\n", n_in, n_in > 0 ? in_sizes[0] : -1, out_size, ws_size); grid = -1; return; }
        int dev = 0, cus = 0;
        if (hipGetDevice(&dev) != hipSuccess || hipDeviceGetAttribute(&cus, hipDeviceAttributeMultiprocessorCount, dev) != hipSuccess) { grid = -1; return; }
        if (hipFuncSetAttribute((const void*)mk_fwd, hipFuncAttributeMaxDynamicSharedMemorySize, LDS_BYTES) != hipSuccess) { fprintf(stderr, "kernel_launch: hipFuncSetAttribute failed\n"); grid = -1; return; }
        (void)hipGetLastError();
        grid = cus;
        if (grid != 256) fprintf(stderr, "kernel_launch: %d CUs, expected 256\n", grid);
    }
    if (grid < 0) return;
    (void)hipMemsetAsync((char*)d_ws + WS_CTL, 0, CTL_ZERO_BYTES, stream);
    Args a{};
    for (int i = 0; i < 20; ++i) a.in[i] = (const float*)d_in[i];
    a.out = (float*)d_out; a.ws = (unsigned char*)d_ws;
    a.ph_lo = 0; a.ph_hi = N_PHASES; a.li = 0;
    hipLaunchKernelGGL(mk_fwd, dim3(grid), dim3(NWAVES * 64), LDS_BYTES, stream, a);
}
```

```cpp
#include <hip/hip_runtime.h>
#include <cstdio>
#include <cstdint>
namespace pg8 {
#define PG8_LAS __attribute__((address_space(3)))
typedef unsigned short bf16_t;
typedef short bf16x8 __attribute__((ext_vector_type(8)));
typedef float f32x4 __attribute__((ext_vector_type(4)));
typedef unsigned u32x4 __attribute__((ext_vector_type(4)));
typedef unsigned u32x2 __attribute__((ext_vector_type(2)));
constexpr int BM = 256, BK = 64, HALF = 128, HTB = HALF * BK * 2  , STAGE_BYTES = 8 * HTB, NXCD = 8, WGM = 8;

__host__ __device__ __forceinline__ int lds_byte(int r, int c) { const int st = (r >> 4) * 2 + (c >> 5), rr = r & 15, cc = c & 31, ob = rr * 64 + cc * 2; return st * 1024 + (ob ^ (((ob >> 9) & 1) << 5)); }
__host__ __device__ __forceinline__ void stage_rc(int b, int& R, int& C) { const int st = b / 1024, sb = b % 1024, swz = sb ^ (((sb >> 9) & 1) << 5); R = (st >> 1) * 16 + swz / 64; C = (st & 1) * 32 + (swz % 64) / 2; }
__host__ __device__ __forceinline__ int perm32(int rho) { const int n = rho >> 4, i = rho & 15; return 8 * (i >> 2) + 4 * n + (i & 3); }

struct Unit { int pm, pn; };
struct Gemm { const bf16_t* A; const bf16_t* Bt; int M, N, K; };

struct StaticOrder {
    int nM, nN, nwg, G, c;
    __host__ __device__ void init(int M, int N, int G_, int c_) { nM = M / BM; nN = N / BM; nwg = nM * nN; G = G_; c = c_; }
    __host__ __device__ bool next(int i, Unit& u) const {
        const long L = (long)i * G + c; if (L >= nwg) return false;
        int wgid = (int)L; { const int q = nwg / NXCD, r = nwg % NXCD, xcd = wgid % NXCD, off = wgid / NXCD; wgid = (xcd < r ? xcd * (q + 1) : r * (q + 1) + (xcd - r) * q) + off; }
        const int nig = WGM * nN, gid = wgid / nig, fm = gid * WGM, gsz = (nM - fm) < WGM ? (nM - fm) : WGM;
        u.pm = fm + ((wgid % nig) % gsz); u.pn = (wgid % nig) / gsz; return true;
    }
    __device__ __forceinline__ void a_ready(const Unit&) const {}
    __device__ __forceinline__ void done(const Unit&) const {}
};

typedef float f32x2_t __attribute__((ext_vector_type(2))); typedef __bf16 bf16x2_t __attribute__((ext_vector_type(2)));
__device__ __forceinline__ unsigned cvt_pk_bf16(float lo, float hi) { const f32x2_t v = {lo, hi}; const bf16x2_t b = __builtin_convertvector(v, bf16x2_t); return __builtin_bit_cast(unsigned, b); }
constexpr int TOK = 16384;
constexpr float NEPS = 1e-6f;
__device__ __forceinline__ float row_rstd(const float* ssq, int row) { const f32x4 s = *(const f32x4*)(ssq + (size_t)row * 4); return rsqrtf(((s[0] + s[1]) + (s[2] + s[3])) * (1.0f / 1024.0f) + NEPS); }

struct EpiIn {
    static constexpr bool PERM = true, AFTER_DRAIN = false;
    bf16_t* P; float* PS; const float* ssq;
    __device__ __forceinline__ void operator()(const f32x4 (&acc)[2][2][4][2], const Unit& u, int wr, int wc, int fr, int fq) const {
        const int row0 = u.pm * BM + wr * 64 + fr;
#pragma unroll
        for (int ai = 0; ai < 2; ++ai)
#pragma unroll
            for (int m = 0; m < 4; ++m) {
                const int row = row0 + ai * HALF + m * 16; const float rs = row_rstd(ssq, row);
                if (u.pn < 13) {
                    bf16_t* rowp = P + (size_t)u.pn * TOK * 256 + (size_t)row * 256 + wc * 32 + 8 * fq;
#pragma unroll
                    for (int bj = 0; bj < 2; ++bj) { const f32x4 v0 = acc[ai][bj][m][0] * rs, v1 = acc[ai][bj][m][1] * rs; u32x4 w;
                        w.x = cvt_pk_bf16(v0[0], v0[1]); w.y = cvt_pk_bf16(v0[2], v0[3]); w.z = cvt_pk_bf16(v1[0], v1[1]); w.w = cvt_pk_bf16(v1[2], v1[3]);
                        *(u32x4*)(rowp + bj * HALF) = w; }
                } else if (wc == 0) {
                    float* rp = PS + (size_t)row * 32 + 8 * fq;
                    *(f32x4*)rp = acc[ai][0][m][0] * rs; *(f32x4*)(rp + 4) = acc[ai][0][m][1] * rs;
                }
            }
    }
};
struct EpiGU {
    static constexpr bool PERM = true, AFTER_DRAIN = false;
    bf16_t* H; const float* ssq;
    __device__ __forceinline__ void operator()(const f32x4 (&acc)[2][2][4][2], const Unit& u, int wr, int wc, int fr, int fq) const {
        const int row0 = u.pm * BM + wr * 64 + fr;
#pragma unroll
        for (int ai = 0; ai < 2; ++ai)
#pragma unroll
            for (int m = 0; m < 4; ++m) {
                const int row = row0 + ai * HALF + m * 16; const float rs = row_rstd(ssq, row);
                float h[8];
#pragma unroll
                for (int n = 0; n < 2; ++n)
#pragma unroll
                    for (int i = 0; i < 4; ++i) { const float g = acc[ai][0][m][n][i] * rs, up = acc[ai][1][m][n][i] * rs; h[n * 4 + i] = g * up * __builtin_amdgcn_rcpf(1.0f + __expf(-g)); }
                u32x4 w; w.x = cvt_pk_bf16(h[0], h[1]); w.y = cvt_pk_bf16(h[2], h[3]); w.z = cvt_pk_bf16(h[4], h[5]); w.w = cvt_pk_bf16(h[6], h[7]);
                *(u32x4*)(H + (size_t)row * 2816 + u.pn * 128 + wc * 32 + 8 * fq) = w;
            }
    }
};
struct EpiRes {
    static constexpr bool PERM = false, AFTER_DRAIN = true;
    const float* xin; float* xout; bf16_t* xb; float* ssq;
    __device__ __forceinline__ void operator()(const f32x4 (&)[2][2][4][2], const Unit&, int, int, int, int) const {}
    __device__ __forceinline__ void fused(f32x4 (&acc)[2][2][4][2], const Unit& u, int wr, int wc, int fr, int fq, PG8_LAS unsigned char* lds, int wid, int lane) const {
        PG8_LAS float* part = (PG8_LAS float*)lds;
        const int col0 = u.pn * BM + wc * 32 + 4 * fq;
#pragma unroll
        for (int ai = 0; ai < 2; ++ai)
#pragma unroll
            for (int m = 0; m < 4; ++m) {
                const int r = ai * HALF + wr * 64 + m * 16 + fr; const size_t off = (size_t)(u.pm * BM + r) * 1024 + col0; float s = 0.f;
#pragma unroll
                for (int bj = 0; bj < 2; ++bj)
#pragma unroll
                    for (int n = 0; n < 2; ++n) { const f32x4 xo = *(const f32x4*)(xin + off + bj * HALF + n * 16); const f32x4 xn = xo + acc[ai][bj][m][n];
                        *(f32x4*)(xout + off + bj * HALF + n * 16) = xn; s += (xn[0] * xn[0] + xn[1] * xn[1]) + (xn[2] * xn[2] + xn[3] * xn[3]);
                        u32x2 w; w.x = cvt_pk_bf16(xn[0], xn[1]); w.y = cvt_pk_bf16(xn[2], xn[3]); *(u32x2*)(xb + off + bj * HALF + n * 16) = w; }
                s += __shfl_xor(s, 16); s += __shfl_xor(s, 32);
                if (fq == 0) part[r * 4 + wc] = s;
            }
        asm volatile("s_waitcnt lgkmcnt(0)" ::: "memory"); __builtin_amdgcn_s_barrier(); asm volatile("" ::: "memory");
        const int t = wid * 64 + lane;
        if (t < 256) { const f32x4 p = *(const PG8_LAS f32x4*)(part + t * 4); ssq[(size_t)(u.pm * BM + t) * 4 + u.pn] = (p[0] + p[1]) + (p[2] + p[3]); }
        asm volatile("s_waitcnt lgkmcnt(0)" ::: "memory"); __builtin_amdgcn_s_barrier(); asm volatile("" ::: "memory");
    }
};

template <class Epi, class Sched, bool ALIGN_EPI = false, bool SP2 = false>
__device__ __forceinline__ void gemm_phase(PG8_LAS unsigned char* lds, const Gemm g, const Sched& S, const Epi& E) {
    int tid_ = threadIdx.x; asm volatile("" : "+v"(tid_));
    const int tid = tid_, wid = __builtin_amdgcn_readfirstlane(tid >> 6), lane = tid & 63, wr = wid >> 2, wc = wid & 3, fr = lane & 15, fq = lane >> 4;
    const int K = g.K, nt = K / BK;
    unsigned voffA[2], voffB[2];
#pragma unroll
    for (int i = 0; i < 2; ++i) { int R, C; stage_rc(tid * 16 + i * 8192, R, C); const int Rb = Epi::PERM ? ((R & ~31) + perm32(R & 31)) : R;
        voffA[i] = (unsigned)(R * K + C) * 2u; voffB[i] = (unsigned)(Rb * K + C) * 2u; }
    const size_t kstep = (size_t)(BK * 2);
    const size_t hstep = (size_t)HALF * K * 2;
    const size_t tstep = 2 * hstep;
    const unsigned ldsw = (unsigned)wid * 1024u;
    const int aoff = lds_byte(wr * 64 + fr, fq * 8), boff = lds_byte(wc * 32 + fr, fq * 8);
#define PG8_SA(b, h) (((b) * 2 + (h)) * HTB)
#define PG8_SB(b, h) ((4 + (b) * 2 + (h)) * HTB)
#define PG8_STAGE(bufoff, gbase, voff) do { _Pragma("unroll") for (int _i = 0; _i < 2; ++_i) \
        __builtin_amdgcn_global_load_lds((const unsigned*)((const char*)(gbase) + (voff)[_i]), (PG8_LAS unsigned*)(lds + (bufoff) + ldsw + _i * 8192), 16, 0, 0); } while (0)
#define PG8_LDA(dst, b, h) do { _Pragma("unroll") for (int m = 0; m < 4; ++m) _Pragma("unroll") for (int k = 0; k < 2; ++k) dst[m][k] = *(const PG8_LAS bf16x8*)(lds + PG8_SA(b, h) + aoff + m * 2048 + k * 1024); } while (0)
#define PG8_LDB(dst, b, h) do { _Pragma("unroll") for (int n = 0; n < 2; ++n) _Pragma("unroll") for (int k = 0; k < 2; ++k) dst[n][k] = *(const PG8_LAS bf16x8*)(lds + PG8_SB(b, h) + boff + n * 2048 + k * 1024); } while (0)
#define PG8_MMA(ai, bj, At, Bt) do { __builtin_amdgcn_s_setprio(1); _Pragma("unroll") for (int m = 0; m < 4; ++m) _Pragma("unroll") for (int n = 0; n < 2; ++n) _Pragma("unroll") for (int k = 0; k < 2; ++k) \
        acc[ai][bj][m][n] = __builtin_amdgcn_mfma_f32_16x16x32_bf16(Bt[n][k], At[m][k], acc[ai][bj][m][n], 0, 0, 0); __builtin_amdgcn_s_setprio(0); } while (0)
#define PG8_WAIT_V(n) asm volatile("s_waitcnt vmcnt(" #n ")" ::: "memory")
#define PG8_WAIT_L(n) asm volatile("s_waitcnt lgkmcnt(" #n ")" ::: "memory")
#define PG8_BAR __builtin_amdgcn_s_barrier()
#define PG8_SCHED __builtin_amdgcn_sched_barrier(0)
    Unit cur, nxt; int ui = 0;
    if (!S.next(0, cur)) return;
    f32x4 acc[2][2][4][2];
#pragma unroll
    for (int a = 0; a < 2; ++a)
#pragma unroll
        for (int b = 0; b < 2; ++b)
#pragma unroll
            for (int m = 0; m < 4; ++m)
#pragma unroll
                for (int n = 0; n < 2; ++n) acc[a][b][m][n] = (f32x4){0.f, 0.f, 0.f, 0.f};
    bf16x8 At[4][2], B0[2][2], B1[2][2];
    const char* cA = (const char*)g.A + (size_t)cur.pm * tstep; const char* cB = (const char*)g.Bt + (size_t)cur.pn * tstep;
    S.a_ready(cur);
    if constexpr (SP2) {
        PG8_STAGE(PG8_SB(0, 0), cB, voffB); PG8_STAGE(PG8_SB(0, 1), cB + hstep, voffB); PG8_STAGE(PG8_SA(0, 0), cA, voffA); PG8_STAGE(PG8_SA(0, 1), cA + hstep, voffA);
        if (wr == 1) PG8_BAR;
        PG8_WAIT_V(2); PG8_BAR;
        PG8_STAGE(PG8_SB(1, 0), cB + kstep, voffB); PG8_STAGE(PG8_SA(1, 0), cA + kstep, voffA); PG8_STAGE(PG8_SB(1, 1), cB + hstep + kstep, voffB);
        PG8_WAIT_V(6); PG8_BAR;
    } else {
        PG8_STAGE(PG8_SB(0, 0), cB, voffB); PG8_STAGE(PG8_SA(0, 0), cA, voffA); PG8_STAGE(PG8_SB(0, 1), cB + hstep, voffB); PG8_STAGE(PG8_SA(0, 1), cA + hstep, voffA);
        if (wr == 1) PG8_BAR;
        PG8_WAIT_V(4); PG8_BAR;
        PG8_STAGE(PG8_SB(1, 0), cB + kstep, voffB); PG8_STAGE(PG8_SA(1, 0), cA + kstep, voffA); PG8_STAGE(PG8_SB(1, 1), cB + hstep + kstep, voffB);
        PG8_WAIT_V(6); PG8_BAR;
    }
    for (;;) {
        const bool has_next = S.next(ui + 1, nxt);
        const char* nA = has_next ? (const char*)g.A + (size_t)nxt.pm * tstep : cA; const char* nB = has_next ? (const char*)g.Bt + (size_t)nxt.pn * tstep : cB;
        for (int t = 0; t < nt; t += 2) {
            const bool last = (t == nt - 2);
            const char* a1 = cA + (size_t)(t + 1) * kstep;
            const char* a2 = last ? nA : cA + (size_t)(t + 2) * kstep; const char* b2 = last ? nB : cB + (size_t)(t + 2) * kstep;
            const char* a3 = a2 + kstep; const char* b3 = b2 + kstep;
            if (last && has_next) S.a_ready(nxt);
            if constexpr (SP2) {
            PG8_LDB(B0, 0, 0); PG8_LDB(B1, 0, 1); PG8_SCHED; PG8_LDA(At, 0, 0); PG8_STAGE(PG8_SA(1, 1), a1 + hstep, voffA);
            PG8_WAIT_V(8); PG8_WAIT_L(0); PG8_BAR; PG8_MMA(0, 0, At, B0); PG8_MMA(0, 1, At, B1); PG8_BAR; PG8_SCHED;
            PG8_LDA(At, 0, 1); PG8_STAGE(PG8_SB(0, 0), b2, voffB); PG8_STAGE(PG8_SB(0, 1), b2 + hstep, voffB); PG8_STAGE(PG8_SA(0, 0), a2, voffA);
            PG8_WAIT_V(8); PG8_WAIT_L(0); PG8_BAR; PG8_MMA(1, 0, At, B0); PG8_MMA(1, 1, At, B1); PG8_BAR; PG8_SCHED;
            PG8_LDB(B0, 1, 0); PG8_LDB(B1, 1, 1); PG8_SCHED; PG8_LDA(At, 1, 0); PG8_STAGE(PG8_SA(0, 1), a2 + hstep, voffA);
            PG8_WAIT_V(8); PG8_WAIT_L(0); PG8_BAR; PG8_MMA(0, 0, At, B0); PG8_MMA(0, 1, At, B1); PG8_BAR; PG8_SCHED;
            PG8_LDA(At, 1, 1); PG8_STAGE(PG8_SB(1, 0), b3, voffB); PG8_STAGE(PG8_SB(1, 1), b3 + hstep, voffB); PG8_STAGE(PG8_SA(1, 0), a3, voffA);
            PG8_WAIT_V(8); PG8_WAIT_L(0); PG8_BAR; PG8_MMA(1, 0, At, B0); PG8_MMA(1, 1, At, B1); PG8_BAR; PG8_SCHED;
            } else {
            PG8_LDB(B0, 0, 0); PG8_SCHED; PG8_LDA(At, 0, 0); PG8_STAGE(PG8_SA(1, 1), a1 + hstep, voffA);
            PG8_WAIT_L(8); PG8_BAR; PG8_WAIT_L(0); PG8_MMA(0, 0, At, B0); PG8_BAR; PG8_SCHED;
            PG8_LDB(B1, 0, 1); PG8_STAGE(PG8_SB(0, 0), b2, voffB);
            PG8_BAR; PG8_WAIT_L(0); PG8_MMA(0, 1, At, B1); PG8_BAR;
            PG8_LDA(At, 0, 1); PG8_STAGE(PG8_SA(0, 0), a2, voffA);
            PG8_BAR; PG8_WAIT_L(0); PG8_MMA(1, 0, At, B0); PG8_BAR; PG8_SCHED;
            PG8_STAGE(PG8_SB(0, 1), b2 + hstep, voffB);
            PG8_WAIT_V(6); PG8_BAR; PG8_MMA(1, 1, At, B1); PG8_BAR;
            PG8_LDB(B0, 1, 0); PG8_SCHED; PG8_LDA(At, 1, 0); PG8_STAGE(PG8_SA(0, 1), a2 + hstep, voffA);
            PG8_WAIT_L(8); PG8_BAR; PG8_WAIT_L(0); PG8_MMA(0, 0, At, B0); PG8_BAR; PG8_SCHED;
            PG8_LDB(B1, 1, 1); PG8_STAGE(PG8_SB(1, 0), b3, voffB);
            PG8_BAR; PG8_WAIT_L(0); PG8_MMA(0, 1, At, B1); PG8_BAR;
            PG8_LDA(At, 1, 1); PG8_STAGE(PG8_SA(1, 0), a3, voffA);
            PG8_BAR; PG8_WAIT_L(0); PG8_MMA(1, 0, At, B0); PG8_BAR; PG8_SCHED;
            PG8_STAGE(PG8_SB(1, 1), b3 + hstep, voffB);
            PG8_WAIT_V(6); PG8_BAR; PG8_MMA(1, 1, At, B1); PG8_BAR;
            }
        }
        if constexpr (ALIGN_EPI) { if (wr == 0) PG8_BAR; }
        if constexpr (!Epi::AFTER_DRAIN) { E(acc, cur, wr, wc, fr, fq); S.done(cur); }
        if (!has_next) break;
#pragma unroll
        for (int a = 0; a < 2; ++a)
#pragma unroll
            for (int b = 0; b < 2; ++b)
#pragma unroll
                for (int m = 0; m < 4; ++m)
#pragma unroll
                    for (int n = 0; n < 2; ++n) acc[a][b][m][n] = (f32x4){0.f, 0.f, 0.f, 0.f};
        cur = nxt; cA = nA; cB = nB; ++ui;
        if constexpr (ALIGN_EPI) { if (wr == 1) PG8_BAR; }
    }
    PG8_WAIT_V(0);
    if constexpr (!ALIGN_EPI) { if (wr == 0) PG8_BAR; }
    PG8_BAR;
    if constexpr (Epi::AFTER_DRAIN) { E.fused(acc, cur, wr, wc, fr, fq, lds, wid, lane); S.done(cur); }
#undef PG8_SA
#undef PG8_SB
#undef PG8_STAGE
#undef PG8_LDA
#undef PG8_LDB
#undef PG8_MMA
#undef PG8_WAIT_V
#undef PG8_WAIT_L
#undef PG8_BAR
#undef PG8_SCHED
}
}

constexpr int NWAVES = 8;
constexpr int BATCH = 2, SEQ = 8192, D = 1024, M = BATCH * SEQ, G = 256, NH = 4, HD = 64, DFF = 2816, DEPTH = 2;
constexpr int IN_COLS = 3352, NIN = 3584  , NGU = 2 * DFF;
constexpr float EPS = 1e-6f;
enum { T_AU = 0, T_AV, T_BB, T_BC, T_BH, T_CQ, T_CK, T_CV, T_CZ, T_DQ, T_DK, T_DV, T_DZ, NPT };
constexpr size_t MiB = 1u << 20;
constexpr size_t WS_CTL = 0, CTL_ZERO_BYTES = 1 * MiB;
constexpr size_t WS_SSQ1 = 1 * MiB, WS_SSQ2 = WS_SSQ1 + 256 * 1024;
constexpr size_t WS_PS = 2 * MiB;
constexpr size_t WS_W0 = 4 * MiB;
constexpr size_t WOFF_IN = 0, WOFF_OUT = 7 * MiB, WOFF_GU = 9 * MiB, WOFF_DN = 20 * MiB;
constexpr size_t WS_XB = 30 * MiB;
constexpr size_t WS_MIX = 62 * MiB;
constexpr size_t WS_P = 94 * MiB;
constexpr size_t WS_OL = 198 * MiB;
constexpr size_t WS_QT = 230 * MiB;
constexpr size_t WS_AN = 246 * MiB;
constexpr size_t WS_DEC = 254 * MiB;
constexpr size_t WS_BN = WS_XB;
constexpr size_t WS_SN = WS_P + (size_t)T_CQ * M * 256 * 2;
constexpr size_t WS_TMP = 198 * MiB;
constexpr size_t WS_END = 256 * MiB;
static_assert(WS_P + (size_t)NPT * M * 256 * 2 <= WS_OL && (size_t)M * DFF * 2 <= WS_OL - WS_P, "ws map");
constexpr int CW_TMO = 0, CW_CODE = 1, CW_BAR = 4096;
constexpr int RING_OFF = 0, RING_BYTES = 131072;
constexpr int HALF_LDS = 73728;
constexpr int LDSCTL_OFF = 2 * HALF_LDS, MISC_OFF = LDSCTL_OFF + 320;
constexpr int LDS_BYTES = 163840;

#define GAS __attribute__((address_space(1)))
#define LAS __attribute__((address_space(3)))
typedef unsigned short bf16;
typedef unsigned v4u __attribute__((ext_vector_type(4)));
typedef unsigned v2u __attribute__((ext_vector_type(2)));
typedef float f32x4 __attribute__((ext_vector_type(4)));
typedef float f32x2 __attribute__((ext_vector_type(2)));
typedef short bf16x8 __attribute__((ext_vector_type(8)));
typedef GAS unsigned gu32;
#define RLX_AGENT __ATOMIC_RELAXED, __HIP_MEMORY_SCOPE_AGENT
#define LDS_WAIT() asm volatile("s_waitcnt lgkmcnt(0)" ::: "memory")
#define VM_WAIT() asm volatile("s_waitcnt vmcnt(0)" ::: "memory")
__device__ __forceinline__ unsigned f2bf(float f) { unsigned u = __builtin_bit_cast(unsigned, f); return (u + 0x7fffu + ((u >> 16) & 1u)) >> 16; }
__device__ __forceinline__ unsigned pk2(float lo, float hi) { return f2bf(lo) | (f2bf(hi) << 16); }
__device__ __forceinline__ float bf2f(unsigned short b) { return __builtin_bit_cast(float, (unsigned)b << 16); }
__device__ __forceinline__ float bflo(unsigned w) { return __builtin_bit_cast(float, w << 16); }
__device__ __forceinline__ float bfhi(unsigned w) { return __builtin_bit_cast(float, w & 0xffff0000u); }
__device__ __forceinline__ float siluf(float x) { return x * __builtin_amdgcn_rcpf(1.0f + __expf(-x)); }
__device__ __forceinline__ float sigmoidf(float x) { return __builtin_amdgcn_rcpf(1.0f + __expf(-x)); }
__device__ __forceinline__ float softplusf(float x) { return fmaxf(x, 0.f) + __logf(1.0f + __expf(-fabsf(x))); }
__device__ __forceinline__ float geluf(float x) { const float u2 = 1.5957691216057308f * (x + 0.044715f * x * x * x); return x * __builtin_amdgcn_rcpf(1.0f + __expf(-u2)); }
__device__ __forceinline__ float wave_sum(float v) {
#pragma unroll
    for (int o = 1; o < 64; o <<= 1) v += __shfl_xor(v, o);
    return v;
}
#define XB_TMO      128
#define XB_XCNT(j)  (256  + 64 * (j))
#define XB_XSUB(j)  (1280 + 64 * (j))
#define XB_XGEN(j)  (2304 + 64 * (j))
#define XB_TOP      3328
#define XB_TOPGEN   3392
#define XCD_BAR_WORDS 3456
#define XB_SPIN_CAP (1u << 18)

__device__ __forceinline__ unsigned xb_ld(unsigned* p)              { return __hip_atomic_load(p, __ATOMIC_RELAXED, __HIP_MEMORY_SCOPE_AGENT); }
__device__ __forceinline__ unsigned xb_add(unsigned* p, unsigned v) { return __hip_atomic_fetch_add(p, v, __ATOMIC_RELAXED, __HIP_MEMORY_SCOPE_AGENT); }
__device__ __forceinline__ unsigned xb_xcc_id() { return (unsigned)__builtin_amdgcn_s_getreg((3 << 11) | 20) & 0xFu; }
#define XB_SPIN(cond, bar) do { unsigned _sp = 0; while (cond) { __builtin_amdgcn_s_sleep(1); \
    if ((++_sp & 255u) == 0u) { if (xb_ld(&(bar)[XB_TMO])) break; if (_sp > XB_SPIN_CAP) { atomicAdd(&(bar)[XB_TMO], 1u); break; } } } } while (0)

struct XcdBarrier {
    unsigned* bar; unsigned x;
    volatile LAS unsigned* st;
};

__device__ __forceinline__ XcdBarrier xcd_barrier_post(unsigned* bar, volatile LAS unsigned* st) {
    XcdBarrier b; b.bar = bar; b.x = xb_xcc_id(); b.st = st;
    if (threadIdx.x == 0) (void)xb_add(&bar[XB_XCNT(b.x)], 1u);
    return b;
}
__device__ __forceinline__ void xcd_barrier_complete(unsigned* bar, unsigned x, unsigned& nloc, unsigned& nx) {
    const unsigned G = gridDim.x * gridDim.y * gridDim.z;
    unsigned sum, cnt, mine, sp = 0u;
    for (;;) {
        sum = 0u; cnt = 0u; mine = 0u;
#pragma unroll
        for (unsigned j = 0; j < 16; ++j) { const unsigned c = xb_ld(&bar[XB_XCNT(j)]); sum += c; cnt += (c > 0u) ? 1u : 0u; mine = (j == x) ? c : mine; }
        if (sum == G) break;
        __builtin_amdgcn_s_sleep(1);
        if ((++sp & 255u) == 0u) { if (xb_ld(&bar[XB_TMO])) break; if (sp > XB_SPIN_CAP) { atomicAdd(&bar[XB_TMO], 1u); break; } }
    }
    nloc = mine > 0u ? mine : 1u; nx = cnt > 0u ? cnt : 1u;
}

__device__ __forceinline__ void xcd_barrier(const XcdBarrier& b) {
    asm volatile("s_waitcnt vmcnt(0)" ::: "memory");
    __syncthreads();
    if (threadIdx.x == 0) {
        unsigned* bar = b.bar;
        __builtin_amdgcn_s_waitcnt(0);
        unsigned nloc = b.st[0], nx = b.st[1];
        if (nloc == 0u) { xcd_barrier_complete(bar, b.x, nloc, nx); b.st[0] = nloc; b.st[1] = nx; }
        const unsigned old = xb_add(&bar[XB_XSUB(b.x)], 1u);
        const unsigned gen = old / nloc;
        if (old + 1u == (gen + 1u) * nloc) {
            __builtin_amdgcn_fence(__ATOMIC_RELEASE, "agent");
            asm volatile("s_waitcnt vmcnt(0)" ::: "memory");
            const unsigned og = xb_add(&bar[XB_TOP], 1u);
            const unsigned tg = og / nx;
            if (og + 1u == (tg + 1u) * nx) xb_add(&bar[XB_TOPGEN], 1u);
            else XB_SPIN(xb_ld(&bar[XB_TOPGEN]) == tg, bar);
            __builtin_amdgcn_fence(__ATOMIC_ACQUIRE, "agent");
            xb_add(&bar[XB_XGEN(b.x)], 1u);
            asm volatile("s_waitcnt vmcnt(0)" ::: "memory");
        } else {
            XB_SPIN(xb_ld(&bar[XB_XGEN(b.x)]) == gen, bar);
            __builtin_amdgcn_fence(__ATOMIC_ACQUIRE, "agent");
            asm volatile("s_waitcnt vmcnt(0)" ::: "memory");
        }
    }
    __syncthreads();
}

struct Args { const float* in[20]; float* out; unsigned char* ws; int ph_lo, ph_hi, li, pad; };
enum { I_X = 0, I_N1W, I_WIN, I_SLNW, I_SLNB, I_SWS, I_SBS, I_SCW, I_DCW, I_DALOG, I_DDT, I_DNW, I_GW2, I_GB, I_GNW, I_WOUT, I_N2W, I_WGU, I_WDN, I_FNW };
struct Frame {
    LAS unsigned char* lds;
    volatile LAS unsigned* MISC;
    gu32* ctl;
    int tid, lane, wave;
    int vcu, NG;
};

__device__ __forceinline__ int map_win(int d) {
    const int t = d >> 8, j = d & 255;
    if (t < 8) return d;
    if (t == 8) return 2056 + j; if (t == 9) return 2312 + j; if (t == 10) return 2568 + j; if (t == 11) return 2824 + j; if (t == 12) return 3096 + j;
    if (j < 4) return 2048 + j; if (j < 8) return 2052 + (j - 4); if (j < 24) return 3080 + (j - 8); return -1;
}
__device__ __forceinline__ int map_wgu(int d) { const int t = d >> 8, j = d & 255; return j < 128 ? 128 * t + j : DFF + 128 * t + (j - 128); }
template <int MAP> __device__ __forceinline__ void transpose_item(const float* W, int K, int N, int ND, bf16* WT, const float* kscale, LAS float* scr, int item, int lane) {
    const int nblk = ND / 32, kb = item / nblk, nb = item % nblk, k0 = 64 * kb, d0 = 32 * nb;
    const int dd = d0 + (lane & 31); const int sc = MAP == 1 ? map_win(dd) : (MAP == 2 ? map_wgu(dd) : dd);
#pragma unroll 8
    for (int i = 0; i < 32; ++i) { const int kk = 2 * i + (lane >> 5); float v = sc >= 0 ? W[(size_t)(k0 + kk) * N + sc] : 0.f; if (kscale) v *= kscale[k0 + kk]; scr[kk * 33 + (lane & 31)] = v; }
    LDS_WAIT(); asm volatile("" ::: "memory");
    const int c = lane & 7;
#pragma unroll
    for (int j = 0; j < 4; ++j) { const int n = (lane >> 3) + 8 * j; const LAS float* s = scr + (8 * c) * 33 + n;
        v4u o; o.x = pk2(s[0 * 33], s[1 * 33]); o.y = pk2(s[2 * 33], s[3 * 33]); o.z = pk2(s[4 * 33], s[5 * 33]); o.w = pk2(s[6 * 33], s[7 * 33]);
        *(GAS v4u*)(WT + (size_t)(d0 + n) * K + k0 + 8 * c) = o; }
    LDS_WAIT(); asm volatile("" ::: "memory");
}
constexpr int IT_IN = (D / 64) * (NIN / 32), IT_OUT = (D / 64) * (D / 32), IT_GU = (D / 64) * (NGU / 32), IT_DN = (DFF / 64) * (D / 32), IT_LAYER = IT_IN + IT_OUT + IT_GU + IT_DN;
typedef const __attribute__((address_space(4))) Args* KArgsP;
__device__ __forceinline__ KArgsP kargs2() { KArgsP p = (KArgsP)__builtin_amdgcn_kernarg_segment_ptr(); asm volatile("" : "+s"(p)); return p; }
__device__ __forceinline__ void convert_weights(int layer_in, int layer, int sel_mask, LAS float* scr, int gw, int ngw, int lane) {
#pragma unroll 1
    for (int it = gw; it < IT_LAYER; it += ngw) {
        KArgsP a = kargs2();
        unsigned char* wb = a->ws + WS_W0;
        int r = it;
        if (r < IT_IN) { if (sel_mask & 1) transpose_item<1>(a->in[I_WIN] + (size_t)layer_in * D * IN_COLS, D, IN_COLS, NIN, (bf16*)(wb + WOFF_IN), a->in[I_N1W] + layer_in * D, scr, r, lane); continue; } r -= IT_IN;
        if (r < IT_OUT) { if (sel_mask & 2) transpose_item<0>(a->in[I_WOUT] + (size_t)layer * D * D, D, D, D, (bf16*)(wb + WOFF_OUT), nullptr, scr, r, lane); continue; } r -= IT_OUT;
        if (r < IT_GU) { if (sel_mask & 4) transpose_item<2>(a->in[I_WGU] + (size_t)layer * D * NGU, D, NGU, NGU, (bf16*)(wb + WOFF_GU), a->in[I_N2W] + layer * D, scr, r, lane); continue; } r -= IT_GU;
        if (sel_mask & 8) transpose_item<0>(a->in[I_WDN] + (size_t)layer * DFF * D, DFF, D, D, (bf16*)(wb + WOFF_DN), nullptr, scr, r, lane);
    }
}
__device__ __forceinline__ void x_row_prep(const float* xrow, bf16* orow, float* ssq4, int lane) {
    const GAS f32x4* xr = (const GAS f32x4*)xrow + lane; f32x4 v[4]; float s = 0.f;
#pragma unroll
    for (int j = 0; j < 4; ++j) { v[j] = xr[64 * j]; s += (v[j].x * v[j].x + v[j].y * v[j].y) + (v[j].z * v[j].z + v[j].w * v[j].w); }
    s = wave_sum(s);
    GAS unsigned long long* o8 = (GAS unsigned long long*)orow + lane;
#pragma unroll
    for (int j = 0; j < 4; ++j) o8[64 * j] = (unsigned long long)pk2(v[j].x, v[j].y) | ((unsigned long long)pk2(v[j].z, v[j].w) << 32);
    if (lane == 0) *(f32x4*)ssq4 = (f32x4){s, 0.f, 0.f, 0.f};
}
__device__ __forceinline__ void final_row(float* row, const float* ssq4, const float* fw, int lane) {
    const f32x4 s = *(const f32x4*)ssq4; const float rs = rsqrtf(((s[0] + s[1]) + (s[2] + s[3])) * (1.0f / D) + EPS);
    GAS f32x4* xr = (GAS f32x4*)row + lane; const GAS f32x4* wr = (const GAS f32x4*)fw + lane;
#pragma unroll
    for (int j = 0; j < 4; ++j) { const f32x4 v = xr[64 * j], w = wr[64 * j]; xr[64 * j] = v * rs * w; }
}

typedef const __attribute__((address_space(4))) Args* KArgs;
__device__ __forceinline__ KArgs kargs() { KArgs p = (KArgs)__builtin_amdgcn_kernarg_segment_ptr(); asm volatile("" : "+s"(p)); return p; }
typedef short s16x4 __attribute__((ext_vector_type(4)));
__device__ __forceinline__ s16x4 tr16(const LAS unsigned char* p) { return __builtin_bit_cast(s16x4, __builtin_amdgcn_ds_read_tr16_b64_v4i16((LAS s16x4*)p)); }
__device__ __forceinline__ bf16x8 cat8(s16x4 lo, s16x4 hi) { return __builtin_shufflevector(lo, hi, 0, 1, 2, 3, 4, 5, 6, 7); }
__device__ __forceinline__ unsigned cvtpk(float lo, float hi) { return pg8::cvt_pk_bf16(lo, hi); }
#define MFMA16(a, b, c) __builtin_amdgcn_mfma_f32_16x16x32_bf16((a), (b), (c), 0, 0, 0)
constexpr int SGU_RS = 544;
__device__ __forceinline__ void sgu_item(KArgs a, unsigned char* ws, int l, int ck, LAS unsigned char* sm, int wv, int lane) {
    const bf16* Pav = (const bf16*)(ws + WS_P) + (size_t)T_AV * M * 256; const bf16* Pau = (const bf16*)(ws + WS_P) + (size_t)T_AU * M * 256; bf16* MIX = (bf16*)(ws + WS_MIX);
    const int t0 = ck * 128;
    {
        const f32x4 lw = *(const f32x4*)(a->in[I_SLNW] + l * 256 + 4 * lane), lb = *(const f32x4*)(a->in[I_SLNB] + l * 256 + 4 * lane);
#pragma unroll 8
        for (int rr = 0; rr < 16; ++rr) {
            const int sr = wv * 16 + rr; const v2u w = *(const v2u*)(Pav + (size_t)(t0 + sr) * 256 + 4 * lane);
            float v[4] = {geluf(bflo(w.x)), geluf(bfhi(w.x)), geluf(bflo(w.y)), geluf(bfhi(w.y))};
            float s1 = (v[0] + v[1]) + (v[2] + v[3]), s2 = (v[0] * v[0] + v[1] * v[1]) + (v[2] * v[2] + v[3] * v[3]);
#pragma unroll
            for (int o = 1; o < 64; o <<= 1) { s1 += __shfl_xor(s1, o); s2 += __shfl_xor(s2, o); }
            const float mu = s1 * (1.0f / 256.0f), rstd = rsqrtf(fmaxf(s2 * (1.0f / 256.0f) - mu * mu, 0.f) + EPS);
#pragma unroll
            for (int i = 0; i < 4; ++i) v[i] -= mu;
            v2u o; o.x = cvtpk(v[0] * rstd * lw[0] + lb[0], v[1] * rstd * lw[1] + lb[1]); o.y = cvtpk(v[2] * rstd * lw[2] + lb[2], v[3] * rstd * lw[3] + lb[3]);
            *(LAS v2u*)(sm + sr * SGU_RS + 8 * lane) = o;
        }
    }
    __syncthreads();
    {
        const int h = wv >> 1, cb0 = 2 * (wv & 1), li = lane & 15, g = lane >> 4;
        const float* Wh = a->in[I_SWS] + ((size_t)l * 4 + h) * 128 * 128; const float* bsh = a->in[I_SBS] + (l * 4 + h) * 128;
        const LAS unsigned char* vbase = sm + (8 * g + (li >> 2)) * SGU_RS + (64 * h + 16 * cb0 + 4 * (li & 3)) * 2;
#pragma unroll 1
        for (int tb = 0; tb < 8; ++tb) {
            const int tt = 16 * tb + li; f32x4 acc[2] = {(f32x4){0.f, 0.f, 0.f, 0.f}, (f32x4){0.f, 0.f, 0.f, 0.f}};
            const int nks = (tb >> 1) + 1; const size_t row = (size_t)(t0 + tt);
            f32x4 wq[4][2];
#pragma unroll
            for (int ks = 0; ks < 4; ++ks) if (ks < nks) { const float* wp = Wh + (size_t)tt * 128 + 32 * ks + 8 * g; wq[ks][0] = *(const f32x4*)wp; wq[ks][1] = *(const f32x4*)(wp + 4); }
            v2u uw[2];
#pragma unroll
            for (int cbl = 0; cbl < 2; ++cbl) uw[cbl] = *(const v2u*)(Pau + row * 256 + 64 * h + 16 * (cb0 + cbl) + 4 * g);
            const float bt = bsh[tt];
#pragma unroll
            for (int ks = 0; ks < 4; ++ks) if (ks < nks) {
                const int s0 = 32 * ks + 8 * g; float wf[8] = {wq[ks][0][0], wq[ks][0][1], wq[ks][0][2], wq[ks][0][3], wq[ks][1][0], wq[ks][1][1], wq[ks][1][2], wq[ks][1][3]};
#pragma unroll
                for (int j = 0; j < 8; ++j) if (s0 + j > tt) wf[j] = 0.f;
                v4u wb; wb.x = cvtpk(wf[0], wf[1]); wb.y = cvtpk(wf[2], wf[3]); wb.z = cvtpk(wf[4], wf[5]); wb.w = cvtpk(wf[6], wf[7]);
                const bf16x8 bfrag = __builtin_bit_cast(bf16x8, wb);
#pragma unroll
                for (int cbl = 0; cbl < 2; ++cbl) {
                    const LAS unsigned char* vp = vbase + 32 * ks * SGU_RS + cbl * 32;
                    const bf16x8 afrag = cat8(tr16(vp), tr16(vp + 4 * SGU_RS));
                    acc[cbl] = MFMA16(afrag, bfrag, acc[cbl]);
                }
            }
#pragma unroll
            for (int cbl = 0; cbl < 2; ++cbl) {
                const int c = 64 * h + 16 * (cb0 + cbl) + 4 * g;
                v2u o; o.x = cvtpk(geluf(bflo(uw[cbl].x)) * (acc[cbl][0] + bt), geluf(bfhi(uw[cbl].x)) * (acc[cbl][1] + bt)); o.y = cvtpk(geluf(bflo(uw[cbl].y)) * (acc[cbl][2] + bt), geluf(bfhi(uw[cbl].y)) * (acc[cbl][3] + bt));
                *(v2u*)(MIX + row * D + c) = o;
            }
        }
    }
    __syncthreads();
}
__device__ __forceinline__ void shortconv_task(const bf16* Pbb, const bf16* Pbc, const bf16* Pbh, const float* cw, bf16* MIX, int t, int cg) {
    const int tb = t & (SEQ - 1), c = 8 * cg; float y[8];
#pragma unroll
    for (int i = 0; i < 8; ++i) y[i] = 0.f;
#pragma unroll
    for (int k = 0; k < 3; ++k) { const int o = k - 2;
        if (tb + o >= 0) { const v4u xc = *(const v4u*)(Pbc + (size_t)(t + o) * 256 + c), xh = *(const v4u*)(Pbh + (size_t)(t + o) * 256 + c);
            const f32x4 w0 = *(const f32x4*)(cw + k * 256 + c), w1 = *(const f32x4*)(cw + k * 256 + c + 4);
            y[0] += w0[0] * bflo(xc.x) * bflo(xh.x); y[1] += w0[1] * bfhi(xc.x) * bfhi(xh.x); y[2] += w0[2] * bflo(xc.y) * bflo(xh.y); y[3] += w0[3] * bfhi(xc.y) * bfhi(xh.y);
            y[4] += w1[0] * bflo(xc.z) * bflo(xh.z); y[5] += w1[1] * bfhi(xc.z) * bfhi(xh.z); y[6] += w1[2] * bflo(xc.w) * bflo(xh.w); y[7] += w1[3] * bfhi(xc.w) * bfhi(xh.w); } }
    const v4u xb = *(const v4u*)(Pbb + (size_t)t * 256 + c); v4u o;
    o.x = cvtpk(bflo(xb.x) * y[0], bfhi(xb.x) * y[1]); o.y = cvtpk(bflo(xb.y) * y[2], bfhi(xb.y) * y[3]); o.z = cvtpk(bflo(xb.z) * y[4], bfhi(xb.z) * y[5]); o.w = cvtpk(bflo(xb.w) * y[6], bfhi(xb.w) * y[7]);
    *(v4u*)(MIX + (size_t)t * D + 256 + c) = o;
}

__device__ __forceinline__ v4u pack8(const f32x4& a, const f32x4& b) { v4u w; w.x = cvtpk(a[0], a[1]); w.y = cvtpk(a[2], a[3]); w.z = cvtpk(b[0], b[1]); w.w = cvtpk(b[2], b[3]); return w; }
constexpr int SLOT_BYTES = 10240;
#define RAW_BAR() do { asm volatile("s_waitcnt lgkmcnt(0)" ::: "memory"); __builtin_amdgcn_s_barrier(); asm volatile("" ::: "memory"); } while (0)
struct LdBuf { v4u p[2]; };
__device__ __forceinline__ void ring_issue(LdBuf& b, const unsigned char* src0, const unsigned char* src1, size_t st0, size_t st1, int n) {
    const int nn = n < 127 ? n : 127;
    b.p[0] = *(const v4u*)(src0 + (size_t)nn * st0); b.p[1] = *(const v4u*)(src1 + (size_t)nn * st1);
}
__device__ __forceinline__ void ring_write(const LdBuf& b, LAS unsigned char* slot, int lw, int lane) {
    *(LAS v4u*)(slot + lw * 1024 + lane * 16) = b.p[0]; *(LAS v4u*)(slot + (lw + 5) * 1024 + lane * 16) = b.p[1];
}
__device__ __forceinline__ void scan_wg(unsigned char* ws, int s, int slice, LAS unsigned char* ring, int wv, int lane) {
    const bool gla = s >= 8;
    if (wv >= 1 && wv <= 5) {
        const int lw = wv - 1;
        const unsigned char* bnp = ws + WS_BN + (size_t)s * 128 * 8192 + slice * 2048 + lane * 16; const unsigned char* anp = ws + WS_AN + (size_t)s * 128 * 8192 + lane * 16;
        const unsigned char* decp = ws + WS_DEC + ((size_t)(gla ? s - 8 : 0) * 128 * 64 + 4 * (lane & 15)) * 4;
        const int pc1 = lw + 5;
        const unsigned char* src0 = gla ? decp : anp + lw * 1024; const size_t st0 = gla ? 256 : 8192;
        const unsigned char* src1 = pc1 >= 8 ? bnp + (pc1 - 8) * 1024 : (gla ? decp : anp + pc1 * 1024); const size_t st1 = pc1 >= 8 ? 8192 : (gla ? 256 : 8192);
        LdBuf L0, L1, L2, L3, L4, L5, L6, L7, L8, L9, L10, L11, L12, L13, L14, L15;
#define RI(LB, nn) ring_issue(LB, src0, src1, st0, st1, (nn))
        RI(L0, 0); RI(L1, 1); RI(L2, 2); RI(L3, 3); RI(L4, 4); RI(L5, 5); RI(L6, 6); RI(L7, 7); RI(L8, 8); RI(L9, 9); RI(L10, 10); RI(L11, 11); RI(L12, 12); RI(L13, 13); RI(L14, 14); RI(L15, 15);
        ring_write(L0, ring, lw, lane); RI(L0, 16); ring_write(L1, ring + SLOT_BYTES, lw, lane); RI(L1, 17); RAW_BAR();
#define RING_STEP(LB, j) do { ring_write(LB, ring + (((j) + 2) & 3) * SLOT_BYTES, lw, lane); RI(LB, n0 + (j) + 18); RAW_BAR(); } while (0)
#pragma unroll 1
        for (int n0 = 0; n0 < 128; n0 += 16) { RING_STEP(L2, 0); RING_STEP(L3, 1); RING_STEP(L4, 2); RING_STEP(L5, 3); RING_STEP(L6, 4); RING_STEP(L7, 5); RING_STEP(L8, 6); RING_STEP(L9, 7);
            RING_STEP(L10, 8); RING_STEP(L11, 9); RING_STEP(L12, 10); RING_STEP(L13, 11); RING_STEP(L14, 12); RING_STEP(L15, 13); RING_STEP(L0, 14); RING_STEP(L1, 15); }
#undef RING_STEP
#undef RI
    } else if (wv == 0) {
        const int g = lane >> 4;
        unsigned char* sn = ws + WS_SN + (size_t)s * 128 * 8192 + (size_t)(slice * 2 * 64 + lane) * 16;
        f32x4 S[4];
#pragma unroll
        for (int i = 0; i < 4; ++i) S[i] = (f32x4){0.f, 0.f, 0.f, 0.f};
        struct Ops { v4u a[8]; v4u b[2]; };
        Ops oa, ob;
#define OPS_LOAD(O, slot) do { const LAS unsigned char* sl_ = (slot); \
            if (gla) { _Pragma("unroll") for (int i = 0; i < 4; ++i) (O).a[i] = *(const LAS v4u*)(sl_ + (16 * i + 4 * g) * 4); } \
            else { _Pragma("unroll") for (int i = 0; i < 8; ++i) (O).a[i] = *(const LAS v4u*)(sl_ + i * 1024 + lane * 16); } \
            (O).b[0] = *(const LAS v4u*)(sl_ + 8192 + lane * 16); (O).b[1] = *(const LAS v4u*)(sl_ + 9216 + lane * 16); } while (0)
#define SCAN_STEP(O, ON, n) do { \
            OPS_LOAD(ON, ring + (((n) + 1) & 3) * SLOT_BYTES); __builtin_amdgcn_sched_barrier(0); \
            const v4u f0 = pack8(S[0], S[1]), f1 = pack8(S[2], S[3]); \
            *(v4u*)(sn + (size_t)(n) * 8192) = f0; *(v4u*)(sn + (size_t)(n) * 8192 + 1024) = f1; \
            f32x4 Bv[4]; \
            Bv[0] = (f32x4){bflo((O).b[0].x), bfhi((O).b[0].x), bflo((O).b[0].y), bfhi((O).b[0].y)}; Bv[1] = (f32x4){bflo((O).b[0].z), bfhi((O).b[0].z), bflo((O).b[0].w), bfhi((O).b[0].w)}; \
            Bv[2] = (f32x4){bflo((O).b[1].x), bfhi((O).b[1].x), bflo((O).b[1].y), bfhi((O).b[1].y)}; Bv[3] = (f32x4){bflo((O).b[1].z), bfhi((O).b[1].z), bflo((O).b[1].w), bfhi((O).b[1].w)}; \
            if (gla) { _Pragma("unroll") for (int i = 0; i < 4; ++i) S[i] = __builtin_bit_cast(f32x4, (O).a[i]) * S[i] + Bv[i]; } \
            else { const bf16x8 b0 = __builtin_bit_cast(bf16x8, f0), b1 = __builtin_bit_cast(bf16x8, f1); \
                _Pragma("unroll") for (int i = 0; i < 4; ++i) { const f32x4 acc = MFMA16(__builtin_bit_cast(bf16x8, (O).a[2 * i]), b0, Bv[i]); S[i] = MFMA16(__builtin_bit_cast(bf16x8, (O).a[2 * i + 1]), b1, acc); } } \
            RAW_BAR(); } while (0)
        RAW_BAR();
        OPS_LOAD(oa, ring);
#pragma unroll 1
        for (int n = 0; n < 128; n += 4) { SCAN_STEP(oa, ob, 0); SCAN_STEP(ob, oa, 1); SCAN_STEP(oa, ob, 2); SCAN_STEP(ob, oa, 3); sn += 4 * 8192; }
#undef SCAN_STEP
#undef OPS_LOAD
    } else {
#pragma unroll 1
        for (int n = 0; n < 129; ++n) RAW_BAR();
    }
}
__device__ __forceinline__ void pass3_task(KArgs a, unsigned char* ws, int l, int cid, int i, int lane) {
    const int li = lane & 15, g = lane >> 4, s = cid >> 7, n = cid & 127, kind = s >> 3, b = (s >> 2) & 1, h = s & 3;
    const unsigned char* qt = ws + WS_QT + (size_t)cid * 8192 + (size_t)(i * 2 * 64 + lane) * 16;
    const bf16x8 q0 = *(const bf16x8*)qt, q1 = *(const bf16x8*)(qt + 1024);
    const unsigned char* sn = ws + WS_SN + (size_t)cid * 8192 + (size_t)lane * 16; const unsigned char* ol = ws + WS_OL + (size_t)cid * 16384 + (size_t)(i * 64 + lane) * 16;
    f32x4 o[4]; float ss = 0.f;
#pragma unroll
    for (int cb = 0; cb < 4; ++cb) {
        f32x4 acc = *(const f32x4*)(ol + cb * 4096);
        acc = MFMA16(*(const bf16x8*)(sn + (cb * 2 + 0) * 1024), q0, acc); acc = MFMA16(*(const bf16x8*)(sn + (cb * 2 + 1) * 1024), q1, acc);
        o[cb] = acc; ss += (acc[0] * acc[0] + acc[1] * acc[1]) + (acc[2] * acc[2] + acc[3] * acc[3]);
    }
    ss += __shfl_xor(ss, 16); ss += __shfl_xor(ss, 32);
    const float rstd = rsqrtf(ss * (1.0f / 64.0f) + EPS);
    const size_t row = (size_t)b * SEQ + n * 64 + 16 * i + li;
    const bf16* Pz = (const bf16*)(ws + WS_P) + (size_t)(kind ? T_DZ : T_CZ) * M * 256 + row * 256 + h * 64 + 4 * g;
    bf16* mo = (bf16*)(ws + WS_MIX) + row * D + (kind ? 768 : 512) + h * 64 + 4 * g;
    const float* nw = (kind ? a->in[I_GNW] : a->in[I_DNW]) + l * 64 + 4 * g;
#pragma unroll
    for (int cb = 0; cb < 4; ++cb) {
        const f32x4 w4 = *(const f32x4*)(nw + 16 * cb); const v2u z = *(const v2u*)(Pz + 16 * cb);
        v2u y; y.x = cvtpk(o[cb][0] * rstd * w4[0] * siluf(bflo(z.x)), o[cb][1] * rstd * w4[1] * siluf(bfhi(z.x))); y.y = cvtpk(o[cb][2] * rstd * w4[2] * siluf(bflo(z.y)), o[cb][3] * rstd * w4[3] * siluf(bfhi(z.y)));
        *(v2u*)(mo + 16 * cb) = y;
    }
}
constexpr int CRS = 144;
constexpr int G_QA = 0, G_KA = 9216, G_KL = 18432, G_QG = 27648, G_VR = 36864, G_ATT = 46080, G_GL = 55296, G_PART = 59392, G_MID = 60416, G_LAST = 60672;
__device__ __forceinline__ void gla_pass1(KArgs a, unsigned char* ws, int l, int item, LAS unsigned char* hb, int ht, int hw, int lane) {
    const int n = item & 127, bh = item >> 7, b = bh >> 2, h = bh & 3, t0 = b * SEQ + n * 64, cid = 1024 + item, li = lane & 15, g = lane >> 4;
    const bf16* Pq = (const bf16*)(ws + WS_P) + (size_t)T_DQ * M * 256 + h * 64; const bf16* Pk = (const bf16*)(ws + WS_P) + (size_t)T_DK * M * 256 + h * 64; const bf16* Pv = (const bf16*)(ws + WS_P) + (size_t)T_DV * M * 256 + h * 64;
    const float* PS = (const float*)(ws + WS_PS);
    {
        const int c = ht >> 2, part = ht & 3;
        *(LAS f32x4*)(hb + G_GL + c * 64 + part * 16) = *(const f32x4*)(PS + (size_t)(t0 + c) * 32 + 8 + 4 * part);
        const v4u v0 = *(const v4u*)(Pv + (size_t)(t0 + c) * 256 + part * 16), v1 = *(const v4u*)(Pv + (size_t)(t0 + c) * 256 + part * 16 + 8);
        *(LAS v4u*)(hb + G_VR + c * CRS + part * 32) = v0; *(LAS v4u*)(hb + G_VR + c * CRS + part * 32 + 16) = v1;
    }
    __syncthreads();
    {
        const int d = ht & 63, cq = ht >> 6; float cum[16];
        {
            float w2[16];
#pragma unroll
            for (int r = 0; r < 16; ++r) w2[r] = a->in[I_GW2][(size_t)(l * 16 + r) * 256 + h * 64 + d];
            const float bias = a->in[I_GB][l * 256 + h * 64 + d]; float run = 0.f;
#pragma unroll
            for (int cc = 0; cc < 16; ++cc) {
                const LAS f32x4* gl = (const LAS f32x4*)(hb + G_GL + (16 * cq + cc) * 64); float pre = bias;
#pragma unroll
                for (int r4 = 0; r4 < 4; ++r4) { const f32x4 gv = gl[r4]; pre += gv[0] * w2[4 * r4] + gv[1] * w2[4 * r4 + 1] + gv[2] * w2[4 * r4 + 2] + gv[3] * w2[4 * r4 + 3]; }
                run += -softplusf(-pre) * (1.0f / 16.0f); cum[cc] = run;
            }
            ((LAS float*)(hb + G_PART))[cq * 64 + d] = run;
        }
        __syncthreads();
        float off = 0.f;
#pragma unroll
        for (int q2 = 0; q2 < 3; ++q2) if (q2 < cq) off += ((LAS float*)(hb + G_PART))[q2 * 64 + d];
#pragma unroll
        for (int cc = 0; cc < 16; ++cc) cum[cc] += off;
        if (cq == 2) ((LAS float*)(hb + G_MID))[d] = cum[0];
        if (cq == 3) { ((LAS float*)(hb + G_LAST))[d] = cum[15]; ((float*)(ws + WS_DEC))[(size_t)item * 64 + d] = __expf(cum[15]); }
        __syncthreads();
        const float gmid = ((LAS float*)(hb + G_MID))[d], glast = ((LAS float*)(hb + G_LAST))[d];
#pragma unroll
        for (int cc = 0; cc < 16; ++cc) {
            const int c = 16 * cq + cc; const float gc = cum[cc];
            const float qv = bf2f(Pq[(size_t)(t0 + c) * 256 + d]) * 0.125f, kv = bf2f(Pk[(size_t)(t0 + c) * 256 + d]);
            *(LAS bf16*)(hb + G_QA + c * CRS + 2 * d) = (bf16)f2bf(qv * __expf(gc - gmid));
            *(LAS bf16*)(hb + G_KA + c * CRS + 2 * d) = (bf16)f2bf(kv * __expf(gmid - gc));
            *(LAS bf16*)(hb + G_QG + c * CRS + 2 * d) = (bf16)f2bf(qv * __expf(gc));
            *(LAS bf16*)(hb + G_KL + c * CRS + 2 * d) = (bf16)f2bf(kv * __expf(glast - gc));
        }
    }
    __syncthreads();
    {
        int blk = 0;
#pragma unroll
        for (int bt = 0; bt < 4; ++bt)
#pragma unroll
            for (int bj = 0; bj < 4; ++bj, ++blk) {
                if ((blk & 3) != hw) continue;
                const int t = 16 * bt + li; v2u o;
                if (bj <= bt) {
                    f32x4 acc = (f32x4){0.f, 0.f, 0.f, 0.f};
#pragma unroll
                    for (int ks = 0; ks < 2; ++ks) acc = MFMA16(*(const LAS bf16x8*)(hb + G_KA + (16 * bj + li) * CRS + (32 * ks + 8 * g) * 2), *(const LAS bf16x8*)(hb + G_QA + t * CRS + (32 * ks + 8 * g) * 2), acc);
                    const int j0 = 16 * bj + 4 * g;
#pragma unroll
                    for (int r = 0; r < 4; ++r) if (j0 + r > t) acc[r] = 0.f;
                    o.x = cvtpk(acc[0], acc[1]); o.y = cvtpk(acc[2], acc[3]);
                } else { o.x = 0u; o.y = 0u; }
                *(LAS v2u*)(hb + G_ATT + t * CRS + (16 * bj + 4 * g) * 2) = o;
            }
#pragma unroll
        for (int q2 = 0; q2 < 2; ++q2) {
            const int idx = hw * 2 + q2, i = idx >> 1, ks = idx & 1; const LAS unsigned char* qp = hb + G_QG + (16 * i + li) * CRS + (32 * ks + 4 * g) * 2;
            const v2u lo = *(const LAS v2u*)qp, hi = *(const LAS v2u*)(qp + 32); v4u w; w.x = lo.x; w.y = lo.y; w.z = hi.x; w.w = hi.y;
            *(v4u*)(ws + WS_QT + (size_t)cid * 8192 + (size_t)((i * 2 + ks) * 64 + lane) * 16) = w;
        }
    }
    __syncthreads();
    {
        const int eb = hw;
        const LAS unsigned char* vtr = hb + G_VR + (8 * g + (li >> 2)) * CRS + (16 * eb + 4 * (li & 3)) * 2;
        bf16x8 vf[2];
#pragma unroll
        for (int ks = 0; ks < 2; ++ks) vf[ks] = cat8(tr16(vtr + 32 * ks * CRS), tr16(vtr + (32 * ks + 4) * CRS));
#pragma unroll
        for (int i = 0; i < 4; ++i) {
            f32x4 acc = (f32x4){0.f, 0.f, 0.f, 0.f};
#pragma unroll
            for (int ks = 0; ks < 2; ++ks) if (ks <= (i >> 1)) acc = MFMA16(vf[ks], *(const LAS bf16x8*)(hb + G_ATT + (16 * i + li) * CRS + (32 * ks + 8 * g) * 2), acc);
            *(f32x4*)(ws + WS_OL + (size_t)cid * 16384 + (size_t)((eb * 4 + i) * 64 + lane) * 16) = acc;
            f32x4 bacc = (f32x4){0.f, 0.f, 0.f, 0.f};
            const LAS unsigned char* ktr = hb + G_KL + (8 * g + (li >> 2)) * CRS + (16 * i + 4 * (li & 3)) * 2;
#pragma unroll
            for (int ks = 0; ks < 2; ++ks) bacc = MFMA16(cat8(tr16(ktr + 32 * ks * CRS), tr16(ktr + (32 * ks + 4) * CRS)), vf[ks], bacc);
            { v2u bw; bw.x = cvtpk(bacc[0], bacc[1]); bw.y = cvtpk(bacc[2], bacc[3]); *(v2u*)(ws + WS_BN + (size_t)cid * 8192 + eb * 2048 + (i >> 1) * 1024 + lane * 16 + (i & 1) * 8) = bw; }
        }
    }
    __syncthreads();
}

constexpr int NRS = 272;
constexpr int D_RAW = 0, D_NLOW = 0, D_ATT = 17408, D_Q = 26624, D_K = 35840, D_KD = 45056, D_V = 54272, D_TII = 63488, D_GC = 67584, D_CW = 68608;
static_assert(D_CW + 3072 <= HALF_LDS && 3 * 67 * 128 <= D_Q, "DeltaNet LDS map");
#define MFMA4(a, b, c) __builtin_amdgcn_mfma_f32_16x16x4f32((a), (b), (c), 0, 0, 0)
__device__ __forceinline__ void dn_pass1(KArgs a, unsigned char* ws, int l, int item, LAS unsigned char* hb, int ht, int hw, int lane) {
    const int n = item & 127, bh = item >> 7, b = bh >> 2, h = bh & 3, t0 = b * SEQ + n * 64, cid = item, li = lane & 15, g = lane >> 4;
    LAS float* GC = (LAS float*)(hb + D_GC);
    {
        {
            v4u rv[3][3];
#pragma unroll
            for (int X = 0; X < 3; ++X) {
                const bf16* PX = (const bf16*)(ws + WS_P) + (size_t)(T_CQ + X) * M * 256 + h * 64;
#pragma unroll
                for (int q3 = 0; q3 < 3; ++q3) { const int pi = ht + 256 * q3, r = pi >> 3, p8 = pi & 7; rv[X][q3] = (v4u){0u, 0u, 0u, 0u};
                    if (pi < 67 * 8 && n * 64 + r - 3 >= 0) rv[X][q3] = *(const v4u*)(PX + (size_t)(t0 + r - 3) * 256 + p8 * 8); }
            }
#pragma unroll
            for (int X = 0; X < 3; ++X)
#pragma unroll
                for (int q3 = 0; q3 < 3; ++q3) { const int pi = ht + 256 * q3, r = pi >> 3, p8 = pi & 7; if (pi < 67 * 8) *(LAS v4u*)(hb + D_RAW + X * 67 * 128 + r * 128 + p8 * 16) = rv[X][q3]; }
        }
        { const float* dcw = a->in[I_DCW] + (size_t)l * 4 * 768;
#pragma unroll
          for (int q3 = 0; q3 < 3; ++q3) { const int idx = ht + 256 * q3, X = idx >> 8, j = (idx >> 6) & 3, d = idx & 63; ((LAS float*)(hb + D_CW))[idx] = dcw[j * 768 + X * 256 + h * 64 + d]; } }
        if (hw == 0) {
            const float* PS = (const float*)(ws + WS_PS) + (size_t)(t0 + lane) * 32;
            float gv = -__expf(a->in[I_DALOG][l * 4 + h]) * softplusf(PS[h] + a->in[I_DDT][l * 4 + h]);
#pragma unroll
            for (int o = 1; o < 64; o <<= 1) { const float up = __shfl_up(gv, o); if (lane >= o) gv += up; }
            const float glast = __shfl(gv, 63);
            GC[lane] = gv; GC[64 + lane] = sigmoidf(PS[4 + h]); GC[128 + lane] = __expf(gv); GC[192 + lane] = __expf(glast - gv);
        }
    }
    __syncthreads();
    {
        const int c = ht >> 2, d0 = 16 * (ht & 3);
#pragma unroll
        for (int X = 0; X < 3; ++X) {
            float acc[16];
#pragma unroll
            for (int i = 0; i < 16; ++i) acc[i] = 0.f;
#pragma unroll
            for (int j = 0; j < 4; ++j) {
                const LAS unsigned char* rp = hb + D_RAW + X * 67 * 128 + (c + j) * 128 + d0 * 2; const v4u x0 = *(const LAS v4u*)rp, x1 = *(const LAS v4u*)(rp + 16);
                const LAS f32x4* wp = (const LAS f32x4*)(hb + D_CW + ((X * 4 + j) * 64 + d0) * 4); const f32x4 w0 = wp[0], w1 = wp[1], w2 = wp[2], w3 = wp[3];
                acc[0] += w0[0] * bflo(x0.x); acc[1] += w0[1] * bfhi(x0.x); acc[2] += w0[2] * bflo(x0.y); acc[3] += w0[3] * bfhi(x0.y);
                acc[4] += w1[0] * bflo(x0.z); acc[5] += w1[1] * bfhi(x0.z); acc[6] += w1[2] * bflo(x0.w); acc[7] += w1[3] * bfhi(x0.w);
                acc[8] += w2[0] * bflo(x1.x); acc[9] += w2[1] * bfhi(x1.x); acc[10] += w2[2] * bflo(x1.y); acc[11] += w2[3] * bfhi(x1.y);
                acc[12] += w3[0] * bflo(x1.z); acc[13] += w3[1] * bfhi(x1.z); acc[14] += w3[2] * bflo(x1.w); acc[15] += w3[3] * bfhi(x1.w);
            }
            float ss = 0.f;
#pragma unroll
            for (int i = 0; i < 16; ++i) { acc[i] = siluf(acc[i]); ss += acc[i] * acc[i]; }
            float sc = 1.0f;
            if (X < 2) { ss += __shfl_xor(ss, 1); ss += __shfl_xor(ss, 2); sc = rsqrtf(ss + EPS) * (X == 0 ? 0.125f : 1.0f); }
#pragma unroll
            for (int i = 0; i < 16; ++i) acc[i] *= sc;
            v4u o0, o1; o0.x = cvtpk(acc[0], acc[1]); o0.y = cvtpk(acc[2], acc[3]); o0.z = cvtpk(acc[4], acc[5]); o0.w = cvtpk(acc[6], acc[7]);
            o1.x = cvtpk(acc[8], acc[9]); o1.y = cvtpk(acc[10], acc[11]); o1.z = cvtpk(acc[12], acc[13]); o1.w = cvtpk(acc[14], acc[15]);
            LAS unsigned char* dst = hb + (X == 0 ? D_Q : (X == 1 ? D_K : D_V)) + c * CRS + d0 * 2;
            *(LAS v4u*)dst = o0; *(LAS v4u*)(dst + 16) = o1;
            if (X == 1) { const float e = GC[192 + c];
                o0.x = cvtpk(acc[0] * e, acc[1] * e); o0.y = cvtpk(acc[2] * e, acc[3] * e); o0.z = cvtpk(acc[4] * e, acc[5] * e); o0.w = cvtpk(acc[6] * e, acc[7] * e);
                o1.x = cvtpk(acc[8] * e, acc[9] * e); o1.y = cvtpk(acc[10] * e, acc[11] * e); o1.z = cvtpk(acc[12] * e, acc[13] * e); o1.w = cvtpk(acc[14] * e, acc[15] * e);
                LAS unsigned char* d2 = hb + D_KD + c * CRS + d0 * 2; *(LAS v4u*)d2 = o0; *(LAS v4u*)(d2 + 16) = o1; }
        }
    }
    __syncthreads();
    {
        int blk = 0;
#pragma unroll
        for (int bi = 0; bi < 4; ++bi)
#pragma unroll
            for (int bj = 0; bj < 4; ++bj, ++blk) {
                if ((blk & 3) != hw) continue;
                const int i = 16 * bi + li;
                if (bj <= bi) {
                    f32x4 aK = (f32x4){0.f, 0.f, 0.f, 0.f}, aQ = aK;
#pragma unroll
                    for (int ks = 0; ks < 2; ++ks) { const bf16x8 kj = *(const LAS bf16x8*)(hb + D_K + (16 * bj + li) * CRS + (32 * ks + 8 * g) * 2);
                        aK = MFMA16(kj, *(const LAS bf16x8*)(hb + D_K + i * CRS + (32 * ks + 8 * g) * 2), aK);
                        aQ = MFMA16(kj, *(const LAS bf16x8*)(hb + D_Q + i * CRS + (32 * ks + 8 * g) * 2), aQ); }
                    const float gci = GC[i], nbi = -GC[64 + i]; const f32x4 gcj = *(const LAS f32x4*)(GC + 16 * bj + 4 * g); const int j0 = 16 * bj + 4 * g;
                    f32x4 nl, at;
#pragma unroll
                    for (int r = 0; r < 4; ++r) { const float dcy = (j0 + r <= i) ? __expf(gci - gcj[r]) : 0.f; at[r] = aQ[r] * dcy; nl[r] = (j0 + r < i) ? nbi * aK[r] * dcy : 0.f; }
                    *(LAS f32x4*)(hb + D_NLOW + i * NRS + j0 * 4) = nl;
                    v2u o; o.x = cvtpk(at[0], at[1]); o.y = cvtpk(at[2], at[3]); *(LAS v2u*)(hb + D_ATT + i * CRS + j0 * 2) = o;
                } else { v2u o; o.x = 0u; o.y = 0u; *(LAS v2u*)(hb + D_ATT + i * CRS + (16 * bj + 4 * g) * 2) = o; }
            }
    }
    __syncthreads();
    if (hw == 0) {
        float x[16];
#pragma unroll
        for (int i = 0; i < 16; ++i) {
            const LAS f32x4* rp = (const LAS f32x4*)(hb + D_NLOW + (16 * g + i) * NRS + 16 * g * 4); float sacc = (i == li) ? 1.0f : 0.f;
#pragma unroll
            for (int j4 = 0; j4 < 4; ++j4) if (4 * j4 < i) { const f32x4 nl = rp[j4];
#pragma unroll
                for (int r = 0; r < 4; ++r) if (4 * j4 + r < i) sacc += nl[r] * x[4 * j4 + r]; }
            x[i] = sacc; ((LAS float*)(hb + D_TII))[(g * 16 + i) * 16 + li] = sacc;
        }
    }
    __syncthreads();
    {
        const int kind = hw >> 1; bf16x8 fr[2][2];
#pragma unroll
        for (int bl = 0; bl < 2; ++bl) {
            const int col = 16 * (2 * (hw & 1) + bl) + li; f32x4 X[4];
#pragma unroll
            for (int I = 0; I < 4; ++I) {
                f32x4 acc; const f32x4 b4 = *(const LAS f32x4*)(GC + 64 + 16 * I + 4 * g), e4 = *(const LAS f32x4*)(GC + 128 + 16 * I + 4 * g);
#pragma unroll
                for (int r = 0; r < 4; ++r) { const int c = 16 * I + 4 * g + r; acc[r] = kind ? bf2f(*(const LAS bf16*)(hb + D_V + c * CRS + col * 2)) * b4[r] : bf2f(*(const LAS bf16*)(hb + D_K + c * CRS + col * 2)) * b4[r] * e4[r]; }
#pragma unroll
                for (int J = 0; J < 4; ++J) if (J < I) { const f32x4 A4 = *(const LAS f32x4*)(hb + D_NLOW + (16 * I + li) * NRS + (16 * J + 4 * g) * 4);
#pragma unroll
                    for (int r = 0; r < 4; ++r) acc = MFMA4(A4[r], X[J][r], acc); }
                const f32x4 T4 = *(const LAS f32x4*)(hb + D_TII + ((I * 16 + li) * 16 + 4 * g) * 4); f32x4 z = (f32x4){0.f, 0.f, 0.f, 0.f};
#pragma unroll
                for (int r = 0; r < 4; ++r) z = MFMA4(T4[r], acc[r], z);
                X[I] = z;
            }
            fr[bl][0] = __builtin_bit_cast(bf16x8, pack8(X[0], X[1])); fr[bl][1] = __builtin_bit_cast(bf16x8, pack8(X[2], X[3]));
        }
        const float dec = GC[128 + 63];
#pragma unroll
        for (int i = 0; i < 4; ++i) {
            bf16x8 kdf[2], atf[2];
#pragma unroll
            for (int ks = 0; ks < 2; ++ks) {
                const LAS unsigned char* kp = hb + D_KD + (32 * ks + 4 * g + (li >> 2)) * CRS + (16 * i + 4 * (li & 3)) * 2; kdf[ks] = cat8(tr16(kp), tr16(kp + 16 * CRS));
                const LAS unsigned char* ap = hb + D_ATT + (16 * i + li) * CRS + (32 * ks + 4 * g) * 2; const v2u lo = *(const LAS v2u*)ap, hi = *(const LAS v2u*)(ap + 32);
                v4u w; w.x = lo.x; w.y = lo.y; w.z = hi.x; w.w = hi.y; atf[ks] = __builtin_bit_cast(bf16x8, w);
            }
            if (kind == 0) {
                f32x4 va[2], vq[2];
#pragma unroll
                for (int bl = 0; bl < 2; ++bl) {
                    f32x4 acc = (f32x4){0.f, 0.f, 0.f, 0.f};
#pragma unroll
                    for (int ks = 0; ks < 2; ++ks) acc = MFMA16(fr[bl][ks], kdf[ks], acc);
                    const int dp0 = 16 * (2 * hw + bl) + 4 * g;
#pragma unroll
                    for (int r = 0; r < 4; ++r) va[bl][r] = ((dp0 + r == 16 * i + li) ? dec : 0.f) - acc[r];
                    f32x4 qacc = (f32x4){0.f, 0.f, 0.f, 0.f};
#pragma unroll
                    for (int ks = 0; ks < 2; ++ks) if (ks <= (i >> 1)) qacc = MFMA16(fr[bl][ks], atf[ks], qacc);
                    const v2u qw = *(const LAS v2u*)(hb + D_Q + (16 * i + li) * CRS + dp0 * 2); const float eg = GC[128 + 16 * i + li];
                    vq[bl][0] = bflo(qw.x) * eg - qacc[0]; vq[bl][1] = bfhi(qw.x) * eg - qacc[1]; vq[bl][2] = bflo(qw.y) * eg - qacc[2]; vq[bl][3] = bfhi(qw.y) * eg - qacc[3];
                }
                *(v4u*)(ws + WS_AN + (size_t)cid * 8192 + (size_t)((i * 2 + hw) * 64 + lane) * 16) = pack8(va[0], va[1]);
                *(v4u*)(ws + WS_QT + (size_t)cid * 8192 + (size_t)((i * 2 + hw) * 64 + lane) * 16) = pack8(vq[0], vq[1]);
            } else {
#pragma unroll
                for (int bl = 0; bl < 2; ++bl) {
                    const int eb = 2 * (hw & 1) + bl; f32x4 acc = (f32x4){0.f, 0.f, 0.f, 0.f};
#pragma unroll
                    for (int ks = 0; ks < 2; ++ks) acc = MFMA16(kdf[ks], fr[bl][ks], acc);
                    { v2u bw; bw.x = cvtpk(acc[0], acc[1]); bw.y = cvtpk(acc[2], acc[3]); *(v2u*)(ws + WS_BN + (size_t)cid * 8192 + eb * 2048 + (i >> 1) * 1024 + lane * 16 + (i & 1) * 8) = bw; }
                    f32x4 oacc = (f32x4){0.f, 0.f, 0.f, 0.f};
#pragma unroll
                    for (int ks = 0; ks < 2; ++ks) if (ks <= (i >> 1)) oacc = MFMA16(fr[bl][ks], atf[ks], oacc);
                    *(f32x4*)(ws + WS_OL + (size_t)cid * 16384 + (size_t)((eb * 4 + i) * 64 + lane) * 16) = oacc;
                }
            }
        }
    }
    __syncthreads();
}

#ifndef PROBE_PH_V
#define PROBE_PH_V -1
#endif
constexpr int PROBE_PH = PROBE_PH_V;
#ifndef PROBE_PART_V
#define PROBE_PART_V 0
#endif
constexpr int PROBE_PART = PROBE_PART_V;
#ifndef PROBE_TS_V
#define PROBE_TS_V 0
#endif
constexpr int PROBE_TS = PROBE_TS_V;
#ifndef PROBE_BKT_V
#define PROBE_BKT_V 500u
#endif
#ifndef PROBE_OFS_V
#define PROBE_OFS_V 0u
#endif
#ifndef PROBE_WG_V
#define PROBE_WG_V 0
#endif
#define TS_BEGIN(k) unsigned long long ts0_ = 0; if (PROBE_TS == (k)) { __syncthreads(); ts0_ = __builtin_amdgcn_s_memrealtime(); }
#define TS_END(k) if (PROBE_TS == (k)) { __syncthreads(); if (l == 0 && bx == PROBE_WG_V && F.tid == 0) __hip_atomic_store(F.ctl + 8, (unsigned)(__builtin_amdgcn_s_memrealtime() - ts0_), RLX_AGENT); }
constexpr int PH_PRO = 0, PH_PER_LAYER = 7, PH_FINAL = 1 + DEPTH * PH_PER_LAYER, N_PHASES = PH_FINAL + 1;
__global__ void __launch_bounds__(NWAVES * 64, 2) mk_fwd(Args args_unused) {
    extern __shared__ __attribute__((aligned(16))) unsigned char lds[];
    Frame F;
    F.lds = (LAS unsigned char*)lds;
    F.MISC = (volatile LAS unsigned*)(F.lds + MISC_OFF);
    F.tid = threadIdx.x; F.lane = F.tid & 63; F.wave = __builtin_amdgcn_readfirstlane(F.tid >> 6);
    F.NG = gridDim.x; { const int bx = blockIdx.x; F.vcu = (F.NG % 8 == 0) ? (bx % 8) * (F.NG / 8) + bx / 8 : bx; }
    for (int u = F.tid; u < (LDS_BYTES - LDSCTL_OFF) / 4; u += NWAVES * 64) ((LAS unsigned*)(F.lds + LDSCTL_OFF))[u] = 0u;
    __syncthreads();
    int lo, hi; { KArgs a = kargs(); lo = a->ph_lo; hi = a->ph_hi; F.ctl = (gu32*)(a->ws + WS_CTL); }
    XcdBarrier bar; bar.bar = (unsigned*)(F.ctl + CW_BAR); bar.x = 0; bar.st = nullptr;
    if (hi - lo > 1) bar = xcd_barrier_post((unsigned*)(F.ctl + CW_BAR), F.MISC + 8);
#pragma unroll 1
    for (int pi = lo; pi < hi; ++pi) {
        const int ph = (PROBE_PH >= 0 && pi > PROBE_PH) ? pi - 1 : pi;
        KArgs a = kargs();
        int NG = F.NG, bx = blockIdx.x, vcu = F.vcu, wv = F.wave; asm volatile("" : "+s"(NG), "+s"(bx), "+s"(vcu), "+s"(wv));
        int lane_l = F.lane; asm volatile("" : "+v"(lane_l));
        const int gw = vcu * NWAVES + wv, ngw = NG * NWAVES;
        unsigned char* const ws = a->ws;
        if (ph == PH_PRO) {
            LAS float* scr = (LAS float*)(F.lds + RING_OFF + wv * 16384);
            convert_weights(0, 0, 1, scr, gw, ngw, lane_l);
            const float* x = a->in[I_X];
#pragma unroll 1
            for (int m = gw; m < M; m += ngw) x_row_prep(x + (size_t)m * D, (bf16*)(ws + WS_XB) + (size_t)m * D, (float*)(ws + WS_SSQ2) + (size_t)m * 4, lane_l);
        } else if (ph == PH_FINAL) {
            float* xres = a->out; const float* fw = a->in[I_FNW];
#pragma unroll 1
            for (int m = gw; m < M; m += ngw) final_row(xres + (size_t)m * D, (float*)(ws + WS_SSQ2) + (size_t)m * 4, fw, lane_l);
            if (PROBE_TS != 0) { __syncthreads(); if (gw == 0 && lane_l == 0) { VM_WAIT(); xres[0] = 1000.0f * (float)((__hip_atomic_load(F.ctl + 8, RLX_AGENT) + PROBE_OFS_V) / PROBE_BKT_V);     } }
        } else {
            const int l = (ph - 1) / PH_PER_LAYER, sub = (ph - 1) % PH_PER_LAYER;
            unsigned char* wb = ws + WS_W0;
            if (sub == 0) {
                pg8::Gemm g{(const bf16*)(ws + WS_XB), (const bf16*)(wb + WOFF_IN), M, NIN, D}; pg8::StaticOrder S; S.init(M, NIN, NG, bx);
                pg8::EpiIn E{(bf16*)(ws + WS_P), (float*)(ws + WS_PS), (const float*)(ws + WS_SSQ2)};
                pg8::gemm_phase<pg8::EpiIn, pg8::StaticOrder, true, true>(F.lds + RING_OFF, g, S, E);
                if (bx >= 128) convert_weights(0, l, 6, (LAS float*)(F.lds + RING_OFF + wv * 16384), (bx - 128) * NWAVES + wv, (NG - 128) * NWAVES, lane_l);
            } else if (sub == 4 || sub == 6) {
                const bool dn = (sub == 6);
                pg8::Gemm g{(const bf16*)(ws + (dn ? WS_P : WS_MIX)), (const bf16*)(wb + (dn ? WOFF_DN : WOFF_OUT)), M, D, dn ? DFF : D}; pg8::StaticOrder S; S.init(M, D, NG, bx);
                float* xres = a->out;
                pg8::EpiRes E{(!dn && l == 0) ? a->in[I_X] : xres, xres, (bf16*)(ws + WS_XB), (float*)(ws + (dn ? WS_SSQ2 : WS_SSQ1))};
                if (NG == 256) pg8::gemm_phase<pg8::EpiRes, pg8::StaticOrder, false, true>(F.lds + RING_OFF, g, S, E);
            } else if (sub == 5) {
                pg8::Gemm g{(const bf16*)(ws + WS_XB), (const bf16*)(wb + WOFF_GU), M, NGU, D}; pg8::StaticOrder S; S.init(M, NGU, NG, bx);
                pg8::EpiGU E{(bf16*)(ws + WS_P), (const float*)(ws + WS_SSQ1)};
                pg8::gemm_phase<pg8::EpiGU, pg8::StaticOrder, true, true>(F.lds + RING_OFF, g, S, E);
                if (bx >= 128) convert_weights(l + 1, l, (l + 1 < DEPTH) ? 9 : 8, (LAS float*)(F.lds + RING_OFF + wv * 16384), (bx - 128) * NWAVES + wv, (NG - 128) * NWAVES, lane_l);
            } else if (sub == 1) {
                { TS_BEGIN(4)
                    const bf16* P = (const bf16*)(ws + WS_P); bf16* MIX = (bf16*)(ws + WS_MIX); const float* scw = a->in[I_SCW] + l * 3 * 256;
                    const int nth = NG * NWAVES * 64;
#pragma unroll 1
                    for (int i = (bx * NWAVES + wv) * 64 + lane_l; i < M * 32; i += nth) shortconv_task(P + (size_t)T_BB * M * 256, P + (size_t)T_BC * M * 256, P + (size_t)T_BH * M * 256, scw, MIX, i >> 5, i & 31);
                  TS_END(4) }
                {
                    const int half = wv >> 2, hw = wv & 3, ht = hw * 64 + lane_l;
                    { TS_BEGIN(2)
#pragma unroll 1
                    for (int it = bx * 2 + half; it < 1024; it += NG * 2) gla_pass1(a, ws, l, it, F.lds + RING_OFF + half * HALF_LDS, ht, hw, lane_l);
                    TS_END(2) }
                    { TS_BEGIN(3)
#pragma unroll 1
                    for (int it = bx * 2 + half; it < 1024; it += NG * 2) dn_pass1(a, ws, l, it, F.lds + RING_OFF + half * HALF_LDS, ht, hw, lane_l);
                    TS_END(3) }
                }
            } else if (sub == 2) {
                if (bx < 64) {
                    { TS_BEGIN(1) scan_wg(ws, bx >> 2, bx & 3, F.lds + RING_OFF, wv, lane_l); TS_END(1) }
                } else if (bx < 64 + 128) { TS_BEGIN(6) sgu_item(a, ws, l, bx - 64, F.lds + RING_OFF, wv, lane_l); TS_END(6) }
            } else {
                { TS_BEGIN(5)
#pragma unroll 1
                for (int i = gw; i < 2048 * 4; i += ngw) pass3_task(a, ws, l, i >> 2, i & 3, lane_l);
                TS_END(5) }
            }
        }
        if (pi + 1 < hi) xcd_barrier(bar);
    }
}

extern "C" void kernel_launch(void* const* d_in, const int* in_sizes, int n_in, void* d_out, int out_size, void* d_ws, size_t ws_size, hipStream_t stream) {
    static int grid = 0;
    if (grid == 0) {
        if (n_in != 20 || in_sizes[0] != M * D || out_size != M * D || ws_size < WS_END) { fprintf(stderr, "kernel_launch: unexpected shapes (n_in %d in0 %d out %d ws %zu)\n", n_in, n_in > 0 ? in_sizes[0] : -1, out_size, ws_size); grid = -1; return; }
        int dev = 0, cus = 0;
        if (hipGetDevice(&dev) != hipSuccess || hipDeviceGetAttribute(&cus, hipDeviceAttributeMultiprocessorCount, dev) != hipSuccess) { grid = -1; return; }
        if (hipFuncSetAttribute((const void*)mk_fwd, hipFuncAttributeMaxDynamicSharedMemorySize, LDS_BYTES) != hipSuccess) { fprintf(stderr, "kernel_launch: hipFuncSetAttribute failed\n"); grid = -1; return; }
        (void)hipGetLastError();
        grid = cus;
        if (grid != 256) fprintf(stderr, "kernel_launch: %d CUs, expected 256\n", grid);
    }
    if (grid < 0) return;
    (void)hipMemsetAsync((char*)d_ws + WS_CTL, 0, CTL_ZERO_BYTES, stream);
    Args a{};
    for (int i = 0; i < 20; ++i) a.in[i] = (const float*)d_in[i];
    a.out = (float*)d_out; a.ws = (unsigned char*)d_ws;
    a.ph_lo = 0; a.ph_hi = N_PHASES + (PROBE_PH >= 0 ? 1 : 0); a.li = 0;
    hipLaunchKernelGGL(mk_fwd, dim3(grid), dim3(NWAVES * 64), LDS_BYTES, stream, a);
}
```
